# Optimizing an MI355X kernel written in HIP

```python
import jax, jax.numpy as jnp
from jax import lax
import numpy as np

D_MODEL = 1024
BATCH = 8
SEQ = 4096
DEPTH = 2

CHUNK = 64
Q_BLOCK = 128
HEAD_DIM = 64
H_A = D_MODEL // 128
H_B = D_MODEL // 128
G_B = 2
HPG_B = H_B // G_B
H_I = D_MODEL // 128
D_I = 32
TOPK_MAX = 256
ROPE_THETA = 500000.0
ROT_DIM = HEAD_DIM // 4
ROT_DIM_I = D_I // 4
D_FF = 4 * D_MODEL
RMS_EPS = 1e-6

W_QA = H_A * HEAD_DIM
W_KA = H_A * HEAD_DIM
W_VA = H_A * HEAD_DIM
W_QB = H_B * HEAD_DIM
W_KB = G_B * HEAD_DIM
W_VB = G_B * HEAD_DIM
W_QI = H_I * D_I
W_KI = D_I
W_WI = H_I
W_GATE = 2 * D_MODEL
N_IN = W_QA + W_KA + W_VA + W_QB + W_KB + W_VB + W_QI + W_KI + W_WI + W_GATE
SPLITS = (W_QA,
          W_QA + W_KA,
          W_QA + W_KA + W_VA,
          W_QA + W_KA + W_VA + W_QB,
          W_QA + W_KA + W_VA + W_QB + W_KB,
          W_QA + W_KA + W_VA + W_QB + W_KB + W_VB,
          W_QA + W_KA + W_VA + W_QB + W_KB + W_VB + W_QI,
          W_QA + W_KA + W_VA + W_QB + W_KB + W_VB + W_QI + W_KI,
          W_QA + W_KA + W_VA + W_QB + W_KB + W_VB + W_QI + W_KI + W_WI)
MIX_A = H_A * HEAD_DIM
MIX_B = H_B * HEAD_DIM

kernel_name = "hybrid_stickbreak_dsa_gated_block"


def rms_norm(x, g):
    xf = x.astype(jnp.float32)
    y = xf * lax.rsqrt(jnp.mean(xf * xf, axis=-1, keepdims=True) + RMS_EPS)
    return (y * g.astype(jnp.float32)).astype(x.dtype)


def rope_tables(seq, rot_dim):
    inv = ROPE_THETA ** (-(jnp.arange(0, rot_dim, 2, dtype=jnp.float32) / rot_dim))
    ang = jnp.arange(seq, dtype=jnp.float32)[:, None] * inv[None, :]
    return jnp.cos(ang), jnp.sin(ang)


def apply_partial_rope(x, cos, sin):
    r = cos.shape[-1] * 2
    xr = x[..., :r].astype(jnp.float32)
    x1, x2 = xr[..., : r // 2], xr[..., r // 2:]
    c = cos[None, :, None, :]
    s = sin[None, :, None, :]
    rot = jnp.concatenate([x1 * c - x2 * s, x2 * c + x1 * s], axis=-1)
    return jnp.concatenate([rot.astype(x.dtype), x[..., r:]], axis=-1)


def to_blocks(a):
    b, s = a.shape[0], a.shape[1]
    return jnp.moveaxis(a.reshape((b, s // Q_BLOCK, Q_BLOCK) + a.shape[2:]), 1, 0)


def from_blocks(a):
    a = jnp.moveaxis(a, 0, 1)
    return a.reshape((a.shape[0], a.shape[1] * a.shape[2]) + a.shape[3:])


def stick_breaking_attention(q, k, v):
    b, s, h, d = q.shape
    scale = d ** -0.5
    key_pos = jnp.arange(s)

    def block(args):
        qb, bi = args
        z = jnp.einsum("bqhd,bkhd->bhqk", qb, k).astype(jnp.float32) * scale
        q_pos = bi * Q_BLOCK + jnp.arange(Q_BLOCK)
        causal = key_pos[None, :] < q_pos[:, None]
        log_beta = jax.nn.log_sigmoid(z)
        log_1m = jnp.where(causal, jax.nn.log_sigmoid(-z), 0.0)
        tail = lax.cumsum(log_1m, axis=3, reverse=True) - log_1m
        log_a = jnp.where(causal, log_beta + tail, -jnp.inf)
        a = jnp.exp(log_a)
        return jnp.einsum("bhqk,bkhd->bqhd", a.astype(v.dtype), v)

    nb = s // Q_BLOCK
    out = lax.map(block, (to_blocks(q), jnp.arange(nb)))
    return from_blocks(out).reshape(b, s, h * d)


def dsa_sparse_attention(q, k, v, q_idx, k_idx, w_idx):
    b, s, g, hg, d = q.shape
    n_keep = min(TOPK_MAX, s // 4)
    scale = d ** -0.5
    key_chunk = jnp.arange(s) // CHUNK
    w_scaled = w_idx.astype(jnp.float32) * (H_I ** -0.5 * D_I ** -0.5)

    def block(args):
        qb, qib, wb, bi = args
        q_chunk = (bi * Q_BLOCK + jnp.arange(Q_BLOCK)) // CHUNK
        rel = jax.nn.relu(jnp.einsum("bqhd,bkd->bqhk", qib, k_idx).astype(jnp.float32))
        iscore = jnp.einsum("bqh,bqhk->bqk", wb, rel)
        admissible = key_chunk[None, :] <= q_chunk[:, None]
        iscore = jnp.where(admissible[None], iscore, -jnp.inf)
        _, idx = lax.top_k(iscore, n_keep)
        kg = jax.vmap(lambda kb, ib: kb[ib])(k, idx)
        vg = jax.vmap(lambda vb, ib: vb[ib])(v, idx)
        valid = (idx // CHUNK) <= q_chunk[None, :, None]
        logits = jnp.einsum("bqghd,bqkgd->bqghk", qb, kg).astype(jnp.float32) * scale
        logits = jnp.where(valid[:, :, None, None, :], logits, -jnp.inf)
        p = jax.nn.softmax(logits, axis=-1)
        return jnp.einsum("bqghk,bqkgd->bqghd", p.astype(vg.dtype), vg)

    nb = s // Q_BLOCK
    out = lax.map(block, (to_blocks(q), to_blocks(q_idx), to_blocks(w_scaled), jnp.arange(nb)))
    return from_blocks(out).reshape(b, s, g * hg * d)


def setup_inputs(seed: int = 0) -> dict:
    key = jax.random.key(seed)
    ks = jax.random.split(key, 11)
    f32 = jnp.float32
    x = jax.random.normal(ks[0], (BATCH, SEQ, D_MODEL), f32)
    g_mix = 1.0 + 0.1 * jax.random.normal(ks[1], (DEPTH, D_MODEL), f32)
    w_in = jax.random.normal(ks[2], (DEPTH, D_MODEL, N_IN), f32) * D_MODEL ** -0.5
    w_up_a = jax.random.normal(ks[3], (DEPTH, MIX_A, D_MODEL), f32) * MIX_A ** -0.5
    w_up_b = jax.random.normal(ks[4], (DEPTH, MIX_B, D_MODEL), f32) * MIX_B ** -0.5
    w_o = jax.random.normal(ks[5], (DEPTH, D_MODEL, D_MODEL), f32) * D_MODEL ** -0.5
    g_mlp = 1.0 + 0.1 * jax.random.normal(ks[6], (DEPTH, D_MODEL), f32)
    w_ff1 = jax.random.normal(ks[7], (DEPTH, D_MODEL, D_FF), f32) * D_MODEL ** -0.5
    w_ff2 = jax.random.normal(ks[8], (DEPTH, D_FF, D_MODEL), f32) * D_FF ** -0.5
    g_final = 1.0 + 0.1 * jax.random.normal(ks[9], (D_MODEL,), f32)
    return {"x": x, "g_mix": g_mix, "w_in": w_in, "w_up_a": w_up_a, "w_up_b": w_up_b,
            "w_o": w_o, "g_mlp": g_mlp, "w_ff1": w_ff1, "w_ff2": w_ff2, "g_final": g_final}


def reference(x, g_mix, w_in, w_up_a, w_up_b, w_o, g_mlp, w_ff1, w_ff2, g_final):
    b, s, _ = x.shape
    cos_b, sin_b = rope_tables(s, ROT_DIM)
    cos_i, sin_i = rope_tables(s, ROT_DIM_I)
    for l in range(DEPTH):
        h = rms_norm(x, g_mix[l])
        proj = h @ w_in[l]
        qa, ka, va, qb, kb, vb, qi, ki, wi, gates = jnp.split(proj, SPLITS, axis=-1)
        qa = qa.reshape(b, s, H_A, HEAD_DIM)
        ka = ka.reshape(b, s, H_A, HEAD_DIM)
        va = va.reshape(b, s, H_A, HEAD_DIM)
        y_a = stick_breaking_attention(qa, ka, va)
        qb = apply_partial_rope(qb.reshape(b, s, H_B, HEAD_DIM), cos_b, sin_b)
        qb = qb.reshape(b, s, G_B, HPG_B, HEAD_DIM)
        kb = apply_partial_rope(kb.reshape(b, s, G_B, HEAD_DIM), cos_b, sin_b)
        vb = vb.reshape(b, s, G_B, HEAD_DIM)
        qi = apply_partial_rope(qi.reshape(b, s, H_I, D_I), cos_i, sin_i)
        ki = apply_partial_rope(ki.reshape(b, s, 1, D_I), cos_i, sin_i)[:, :, 0, :]
        y_b = dsa_sparse_attention(qb, kb, vb, qi, ki, wi)
        gate_a, gate_b = jnp.split(jax.nn.sigmoid(gates), 2, axis=-1)
        merged = gate_a * (y_a @ w_up_a[l]) + gate_b * (y_b @ w_up_b[l])
        x = x + merged @ w_o[l]
        h2 = rms_norm(x, g_mlp[l])
        x = x + jnp.square(jax.nn.relu(h2 @ w_ff1[l])) @ w_ff2[l]
    return rms_norm(x, g_final)
```

```cpp
#include <hip/hip_runtime.h>
#include <hip/hip_bf16.h>
#include <hip/hip_cooperative_groups.h>
#include <cstdio>
namespace cg = cooperative_groups;

#define DI __device__ __forceinline__
typedef unsigned short bf16_t;
typedef __bf16 bf2_t __attribute__((ext_vector_type(2)));
typedef float fl2_t __attribute__((ext_vector_type(2)));
using bf16x8 = __attribute__((ext_vector_type(8))) short;
using s16x4  = __attribute__((ext_vector_type(4))) short;
using f32x16 = __attribute__((ext_vector_type(16))) float;
using f32x4  = __attribute__((ext_vector_type(4))) float;
using u32x4  = __attribute__((ext_vector_type(4))) unsigned;
using u32x2  = __attribute__((ext_vector_type(2))) unsigned;

#define MFMA32(a, b, c) __builtin_amdgcn_mfma_f32_32x32x16_bf16((a), (b), (c), 0, 0, 0)
#define MFMA16(a, b, c) __builtin_amdgcn_mfma_f32_16x16x32_bf16((a), (b), (c), 0, 0, 0)

#ifndef SB_EARLY
#define SB_EARLY 0
#endif

constexpr int T_TOK = 32768, SEQ = 4096, DM = 1024;
constexpr int NPAD_IN = 4736;
constexpr int SROW = 144;

constexpr size_t WT_IN = 0;
constexpr size_t WT_UPA = WT_IN + (size_t)NPAD_IN * 1024 * 2;
constexpr size_t WT_UPB = WT_UPA + (size_t)1024 * 512 * 2;
constexpr size_t WT_O   = WT_UPB + (size_t)1024 * 512 * 2;
constexpr size_t WT_FF1 = WT_O + (size_t)1024 * 1024 * 2;
constexpr size_t WT_FF2 = WT_FF1 + (size_t)4096 * 1024 * 2;
constexpr size_t WT_LAYER = WT_FF2 + (size_t)1024 * 4096 * 2;
constexpr size_t OFF_ROPE = 2 * WT_LAYER;
constexpr size_t OFF_QA = OFF_ROPE + (size_t)SEQ * 24 * 4;
constexpr size_t OFF_KA = OFF_QA + (size_t)T_TOK * 512 * 2;
constexpr size_t OFF_VAT = OFF_KA + (size_t)T_TOK * 512 * 2;
constexpr size_t OFF_QB = OFF_VAT + (size_t)T_TOK * 512 * 2;
constexpr size_t OFF_KB = OFF_QB + (size_t)T_TOK * 512 * 2;
constexpr size_t OFF_VB = OFF_KB + (size_t)T_TOK * 128 * 2;
constexpr size_t OFF_QI = OFF_VB + (size_t)T_TOK * 128 * 2;
constexpr size_t OFF_KI = OFF_QI + (size_t)T_TOK * 256 * 2;
constexpr size_t OFF_WI = OFF_KI + (size_t)T_TOK * 32 * 2;
constexpr size_t OFF_GATES = OFF_WI + (size_t)T_TOK * 8 * 4;
constexpr size_t OFF_PROJ_END = OFF_GATES + (size_t)T_TOK * 2048 * 2;
constexpr size_t OFF_HIDDEN = OFF_QA;
constexpr size_t OFF_Y = OFF_PROJ_END;
constexpr size_t OFF_HBUF = OFF_Y + (size_t)T_TOK * 1024 * 2;
constexpr size_t OFF_END = OFF_HBUF + (size_t)T_TOK * 1024 * 2;
static_assert(OFF_END <= (size_t)512 * 1024 * 1024, "workspace too large");
static_assert(OFF_HIDDEN + (size_t)T_TOK * 4096 * 2 <= OFF_PROJ_END, "hidden alias");

struct Params {
  const float* x; const float* g_mix; const float* w_in; const float* w_up_a; const float* w_up_b;
  const float* w_o; const float* g_mlp; const float* w_ff1; const float* w_ff2; const float* g_final;
  float* out; char* ws;
};

DI unsigned pack2(float a, float b) {
  fl2_t f = {a, b};
  bf2_t r = __builtin_convertvector(f, bf2_t);
  return __builtin_bit_cast(unsigned, r);
}
DI bf16_t f2bf(float a) { return (bf16_t)(pack2(a, 0.f) & 0xffffu); }
DI float bf2f(unsigned short v) { return __uint_as_float(((unsigned)v) << 16); }
DI int crow(int reg, int h) { return (reg & 3) + 8 * (reg >> 2) + 4 * h; }
DI int otid() { int t = threadIdx.x; asm volatile("" : "+v"(t)); return t; }

DI int src_col(int nd, int mode) {
  if (!mode) return nd;
  if (nd < 2560) return nd;
  if (nd < 4608) return nd + 40;
  if (nd < 4648) return nd - 2048;
  return -1;
}
DI void convT(const float* __restrict__ W, int K, int N, bf16_t* __restrict__ WT, int NR, int mode, char* smem) {
  float* tile = (float*)smem;
  const int tid = otid();
  const int kt_n = K / 64, nt_n = NR / 64;
  for (int t = blockIdx.x; t < kt_n * nt_n; t += gridDim.x) {
    const int k0 = (t % kt_n) * 64, n0 = (t / kt_n) * 64;
    const int nl = tid & 63;
    const int sc = src_col(n0 + nl, mode);
    __syncthreads();
#pragma unroll
    for (int r = 0; r < 16; ++r) {
      const int kl = r * 4 + (tid >> 6);
      float v = 0.f;
      if (sc >= 0) v = W[(size_t)(k0 + kl) * N + sc];
      tile[kl * 65 + nl] = v;
    }
    __syncthreads();
    const int nrow = tid >> 2, ks = (tid & 3) * 16;
    u32x4 o0, o1;
#pragma unroll
    for (int j = 0; j < 4; ++j) {
      o0[j] = pack2(tile[(ks + 2 * j) * 65 + nrow], tile[(ks + 2 * j + 1) * 65 + nrow]);
      o1[j] = pack2(tile[(ks + 8 + 2 * j) * 65 + nrow], tile[(ks + 8 + 2 * j + 1) * 65 + nrow]);
    }
    bf16_t* dst = WT + (size_t)(n0 + nrow) * K + k0 + ks;
    *(u32x4*)dst = o0;
    *(u32x4*)(dst + 8) = o1;
  }
}

DI void phase_prep(const Params& p, char* smem) {
  for (int l = 0; l < 2; ++l) {
    char* wl = p.ws + (size_t)l * WT_LAYER;
    convT(p.w_in + (size_t)l * 1024 * 4648, 1024, 4648, (bf16_t*)(wl + WT_IN), NPAD_IN, 1, smem);
    convT(p.w_up_a + (size_t)l * 512 * 1024, 512, 1024, (bf16_t*)(wl + WT_UPA), 1024, 0, smem);
    convT(p.w_up_b + (size_t)l * 512 * 1024, 512, 1024, (bf16_t*)(wl + WT_UPB), 1024, 0, smem);
    convT(p.w_o + (size_t)l * 1024 * 1024, 1024, 1024, (bf16_t*)(wl + WT_O), 1024, 0, smem);
    convT(p.w_ff1 + (size_t)l * 1024 * 4096, 1024, 4096, (bf16_t*)(wl + WT_FF1), 4096, 0, smem);
    convT(p.w_ff2 + (size_t)l * 4096 * 1024, 4096, 1024, (bf16_t*)(wl + WT_FF2), 1024, 0, smem);
  }
  float* rope = (float*)(p.ws + OFF_ROPE);
  for (int i = blockIdx.x * 256 + threadIdx.x; i < SEQ * 12; i += gridDim.x * 256) {
    const int pos = i / 12, f = i % 12;
    float inv; int co, so;
    if (f < 8) { inv = powf(500000.0f, -((float)(2 * f) / 16.0f)); co = f; so = 8 + f; }
    else { inv = powf(500000.0f, -((float)(2 * (f - 8)) / 8.0f)); co = 16 + (f - 8); so = 20 + (f - 8); }
    const float ang = (float)pos * inv;
    float s, c; sincosf(ang, &s, &c);
    rope[pos * 24 + co] = c; rope[pos * 24 + so] = s;
  }
}

template <bool FINAL>
DI void phase_rmsnorm(const float* __restrict__ xin, const float* __restrict__ g, bf16_t* __restrict__ hout, float* __restrict__ fout) {
  const int tid_ = otid(); const int wave = tid_ >> 6, lane = tid_ & 63;
  for (int t = blockIdx.x * 4 + wave; t < T_TOK; t += gridDim.x * 4) {
    const float4* src = (const float4*)(xin + (size_t)t * DM);
    float4 v[4]; float ss = 0.f;
#pragma unroll
    for (int i = 0; i < 4; ++i) { v[i] = src[lane + 64 * i]; ss += v[i].x * v[i].x + v[i].y * v[i].y + v[i].z * v[i].z + v[i].w * v[i].w; }
#pragma unroll
    for (int o = 32; o > 0; o >>= 1) ss += __shfl_xor(ss, o);
    const float r = rsqrtf(ss * (1.0f / DM) + 1e-6f);
#pragma unroll
    for (int i = 0; i < 4; ++i) {
      const float4 gg = ((const float4*)g)[lane + 64 * i];
      const float a = v[i].x * r * gg.x, b = v[i].y * r * gg.y, c = v[i].z * r * gg.z, d = v[i].w * r * gg.w;
      if (FINAL) { float4 o4; o4.x = a; o4.y = b; o4.z = c; o4.w = d; ((float4*)(fout + (size_t)t * DM))[lane + 64 * i] = o4; }
      else { u32x2 o2; o2[0] = pack2(a, b); o2[1] = pack2(c, d); *(u32x2*)(hout + (size_t)t * DM + (lane + 64 * i) * 4) = o2; }
    }
  }
}

DI void gemm_tile(const bf16_t* __restrict__ A, int lda, const bf16_t* __restrict__ Bt, int ldb, int K, int m0, int n0,
                  f32x16 (&acc)[2][2], char* smem) {
  char* sA = smem; char* sB = smem + 128 * SROW;
  const int tid = otid(), lane = tid & 63, wave = tid >> 6;
  const int wm = wave >> 1, wn = wave & 1, r = lane & 31, h = lane >> 5;
  u32x4 ra[4], rb[4];
  const int lrow = tid >> 3, lkc = tid & 7;
  const bf16_t* ga = A + (size_t)(m0 + lrow) * lda + lkc * 8;
  const bf16_t* gb = Bt + (size_t)(n0 + lrow) * ldb + lkc * 8;
#pragma unroll
  for (int c = 0; c < 4; ++c) { ra[c] = *(const u32x4*)(ga + (size_t)(32 * c) * lda); rb[c] = *(const u32x4*)(gb + (size_t)(32 * c) * ldb); }
  const int KT = K / 64;
  for (int kt = 0; kt < KT; ++kt) {
    __syncthreads();
#pragma unroll
    for (int c = 0; c < 4; ++c) {
      *(u32x4*)(sA + (lrow + 32 * c) * SROW + lkc * 16) = ra[c];
      *(u32x4*)(sB + (lrow + 32 * c) * SROW + lkc * 16) = rb[c];
    }
    __syncthreads();
    if (kt + 1 < KT) {
      const int k0 = (kt + 1) * 64;
#pragma unroll
      for (int c = 0; c < 4; ++c) { ra[c] = *(const u32x4*)(ga + (size_t)(32 * c) * lda + k0); rb[c] = *(const u32x4*)(gb + (size_t)(32 * c) * ldb + k0); }
    }
#pragma unroll
    for (int ks = 0; ks < 4; ++ks) {
      const int ko = (ks * 16 + 8 * h) * 2;
      const bf16x8 a0 = *(const bf16x8*)(sA + (wm * 64 + r) * SROW + ko);
      const bf16x8 a1 = *(const bf16x8*)(sA + (wm * 64 + 32 + r) * SROW + ko);
      const bf16x8 b0 = *(const bf16x8*)(sB + (wn * 64 + r) * SROW + ko);
      const bf16x8 b1 = *(const bf16x8*)(sB + (wn * 64 + 32 + r) * SROW + ko);
      acc[0][0] = MFMA32(a0, b0, acc[0][0]);
      acc[0][1] = MFMA32(a0, b1, acc[0][1]);
      acc[1][0] = MFMA32(a1, b0, acc[1][0]);
      acc[1][1] = MFMA32(a1, b1, acc[1][1]);
    }
  }
}

DI void zero_acc(f32x16 (&acc)[2][2]) {
#pragma unroll
  for (int i = 0; i < 2; ++i)
#pragma unroll
    for (int j = 0; j < 2; ++j)
#pragma unroll
      for (int e = 0; e < 16; ++e) acc[i][j][e] = 0.f;
}

DI void tile_coord(int idx, int nt, int& mt_i, int& nt_i) {
  const int per = 16 * nt;
  const int grp = idx / per, rem = idx % per;
  nt_i = rem / 16; mt_i = grp * 16 + (rem % 16);
}

DI void phase_inproj(const Params& p, int layer, char* smem) {
  const bf16_t* A = (const bf16_t*)(p.ws + OFF_HBUF);
  const bf16_t* Bt = (const bf16_t*)(p.ws + (size_t)layer * WT_LAYER + WT_IN);
  const float* rope = (const float*)(p.ws + OFF_ROPE);
  bf16_t* qa = (bf16_t*)(p.ws + OFF_QA); bf16_t* ka = (bf16_t*)(p.ws + OFF_KA); bf16_t* vaT = (bf16_t*)(p.ws + OFF_VAT);
  bf16_t* qb = (bf16_t*)(p.ws + OFF_QB); bf16_t* kb = (bf16_t*)(p.ws + OFF_KB); bf16_t* vb = (bf16_t*)(p.ws + OFF_VB);
  bf16_t* qi = (bf16_t*)(p.ws + OFF_QI); bf16_t* ki = (bf16_t*)(p.ws + OFF_KI); float* wi = (float*)(p.ws + OFF_WI);
  bf16_t* gates = (bf16_t*)(p.ws + OFF_GATES);
  const int tid_ = otid(); const int lane = tid_ & 63, wave = tid_ >> 6;
  const int wm = wave >> 1, wn = wave & 1, r = lane & 31, h = lane >> 5;
  constexpr int MT = T_TOK / 128, NT = NPAD_IN / 128;
  for (int idx = blockIdx.x; idx < MT * NT; idx += gridDim.x) {
    int mi, ni; tile_coord(idx, NT, mi, ni);
    f32x16 acc[2][2]; zero_acc(acc);
    gemm_tile(A, 1024, Bt, 1024, 1024, mi * 128, ni * 128, acc, smem);
#pragma unroll
    for (int i = 0; i < 2; ++i)
#pragma unroll
      for (int j = 0; j < 2; ++j) {
        const int cl = wn * 64 + j * 32 + r;
        const int mbase = mi * 128 + wm * 64 + i * 32;
        if (ni < 8) {
          bf16_t* dst = (ni < 4) ? qa : ka;
          const int c = (ni & 3) * 128 + cl;
#pragma unroll
          for (int e = 0; e < 16; ++e) dst[(size_t)(mbase + crow(e, h)) * 512 + c] = f2bf(acc[i][j][e]);
        } else if (ni < 12) {
          const int c = (ni - 8) * 128 + cl; const int hd = c >> 6, d = c & 63;
#pragma unroll
          for (int g = 0; g < 4; ++g) {
            const int tok = mbase + 8 * g + 4 * h; const int b = tok >> 12, pos = tok & 4095;
            u32x2 o; o[0] = pack2(acc[i][j][4 * g], acc[i][j][4 * g + 1]); o[1] = pack2(acc[i][j][4 * g + 2], acc[i][j][4 * g + 3]);
            *(u32x2*)(vaT + ((size_t)((b * 8 + hd) * 64 + d)) * SEQ + pos) = o;
          }
        } else if (ni < 17) {
          const int c = (ni < 16 ? (ni - 12) * 128 : 0) + cl; const int d = cl & 63;
          bf16_t* dst = (ni < 16) ? qb : kb; const int ld = (ni < 16) ? 512 : 128;
#pragma unroll
          for (int e = 0; e < 16; ++e) {
            const int tok = mbase + crow(e, h); const int pos = tok & 4095;
            float v = acc[i][j][e];
            const float pv = __shfl_xor(v, 8);
            if (d < 16) {
              const float cs = rope[pos * 24 + (d & 7)], sn = rope[pos * 24 + 8 + (d & 7)];
              v = (d < 8) ? (v * cs - pv * sn) : (v * cs + pv * sn);
            }
            dst[(size_t)tok * ld + c] = f2bf(v);
          }
        } else if (ni == 17) {
#pragma unroll
          for (int e = 0; e < 16; ++e) vb[(size_t)(mbase + crow(e, h)) * 128 + cl] = f2bf(acc[i][j][e]);
        } else if (ni < 20) {
          const int c = (ni - 18) * 128 + cl; const int d = cl & 31;
#pragma unroll
          for (int e = 0; e < 16; ++e) {
            const int tok = mbase + crow(e, h); const int pos = tok & 4095;
            float v = acc[i][j][e];
            const float pv = __shfl_xor(v, 4);
            if (d < 8) {
              const float cs = rope[pos * 24 + 16 + (d & 3)], sn = rope[pos * 24 + 20 + (d & 3)];
              v = (d < 4) ? (v * cs - pv * sn) : (v * cs + pv * sn);
            }
            qi[(size_t)tok * 256 + c] = f2bf(v);
          }
        } else if (ni < 36) {
          const int c = (ni - 20) * 128 + cl;
#pragma unroll
          for (int g = 0; g < 4; ++g) {
            float sg[4];
#pragma unroll
            for (int rr = 0; rr < 4; ++rr) sg[rr] = 1.0f / (1.0f + __expf(-acc[i][j][4 * g + rr]));
            u32x2 o; o[0] = pack2(sg[0], sg[1]); o[1] = pack2(sg[2], sg[3]);
            *(u32x2*)(gates + ((size_t)((mbase + 8 * g + 4 * h) >> 2) * 2048 + c) * 4) = o;
          }
        } else {
#pragma unroll
          for (int e = 0; e < 16; ++e) {
            const int tok = mbase + crow(e, h); const int pos = tok & 4095;
            float v = acc[i][j][e];
            const float pv = __shfl_xor(v, 4);
            if (cl < 32) {
              if (cl < 8) {
                const float cs = rope[pos * 24 + 16 + (cl & 3)], sn = rope[pos * 24 + 20 + (cl & 3)];
                v = (cl < 4) ? (v * cs - pv * sn) : (v * cs + pv * sn);
              }
              ki[(size_t)tok * 32 + cl] = f2bf(v);
            } else if (cl < 40) {
              wi[(size_t)tok * 8 + (cl - 32)] = v * 0.0625f;
            }
          }
        }
      }
  }
}

DI void mixA_item(const Params& p, int item, char* smem) {
  const bf16_t* qa = (const bf16_t*)(p.ws + OFF_QA); const bf16_t* ka = (const bf16_t*)(p.ws + OFF_KA);
  const bf16_t* vaT = (const bf16_t*)(p.ws + OFF_VAT); bf16_t* Y = (bf16_t*)(p.ws + OFF_Y);
  char* sK = smem; char* sV = smem + 64 * SROW;
  const int tid = otid(), lane = tid & 63, w = tid >> 6, r = lane & 31, h = lane >> 5;
  const int bh = item & 63, qblk = 31 - (item >> 6);
  const int b = bh >> 3, hd = bh & 7;
  const int q0 = qblk * 128;
  const int tq = q0 + 32 * w + r;
  bf16x8 qf[4];
#pragma unroll
  for (int s = 0; s < 4; ++s) qf[s] = *(const bf16x8*)(qa + (size_t)(b * SEQ + tq) * 512 + hd * 64 + 16 * s + 8 * h);
  f32x16 o[2];
#pragma unroll
  for (int e = 0; e < 16; ++e) { o[0][e] = 0.f; o[1][e] = 0.f; }
  float carry = 0.f;
  const int nkt = 2 * qblk + 2;
  const int lrow = tid >> 2, lc = (tid & 3) * 2;
  const bf16_t* gk = ka + (size_t)(b * SEQ + lrow) * 512 + hd * 64 + lc * 8;
  const bf16_t* gv = vaT + ((size_t)((b * 8 + hd) * 64 + lrow)) * SEQ + lc * 8;
  u32x4 rk0, rk1, rv0, rv1;
  {
    const int key0 = (nkt - 1) * 64;
    rk0 = *(const u32x4*)(gk + (size_t)key0 * 512); rk1 = *(const u32x4*)(gk + (size_t)key0 * 512 + 8);
    rv0 = *(const u32x4*)(gv + key0); rv1 = *(const u32x4*)(gv + key0 + 8);
  }
  for (int kt = nkt - 1; kt >= 0; --kt) {
    __syncthreads();
    *(u32x4*)(sK + lrow * SROW + lc * 16) = rk0; *(u32x4*)(sK + lrow * SROW + lc * 16 + 16) = rk1;
    *(u32x4*)(sV + lrow * SROW + lc * 16) = rv0; *(u32x4*)(sV + lrow * SROW + lc * 16 + 16) = rv1;
    __syncthreads();
    if (kt > 0) {
      const int key0 = (kt - 1) * 64;
      rk0 = *(const u32x4*)(gk + (size_t)key0 * 512); rk1 = *(const u32x4*)(gk + (size_t)key0 * 512 + 8);
      rv0 = *(const u32x4*)(gv + key0); rv1 = *(const u32x4*)(gv + key0 + 8);
    }
    const int wq_max = q0 + 32 * w + 31;
#pragma unroll
    for (int sub = 1; sub >= 0; --sub) {
      const int kbase = kt * 64 + 32 * sub;
      if (kbase >= wq_max) continue;
      f32x16 sacc;
#pragma unroll
      for (int e = 0; e < 16; ++e) sacc[e] = 0.f;
#pragma unroll
      for (int s = 0; s < 4; ++s) {
        const bf16x8 kf = *(const bf16x8*)(sK + (32 * sub + r) * SROW + (16 * s + 8 * h) * 2);
        sacc = MFMA32(kf, qf[s], sacc);
      }
      float z[16], L[16];
#pragma unroll
      for (int e = 0; e < 16; ++e) {
        z[e] = sacc[e] * 0.125f;
        const bool valid = (kbase + crow(e, h)) < tq;
        const float ex = __expf(-fabsf(z[e]));
        const float sp = fmaxf(z[e], 0.f) + __logf(1.0f + ex);
        L[e] = valid ? -sp : 0.f;
      }
      float G[4], Go[4];
#pragma unroll
      for (int g = 0; g < 4; ++g) { G[g] = (L[4 * g] + L[4 * g + 1]) + (L[4 * g + 2] + L[4 * g + 3]); Go[g] = __shfl_xor(G[g], 32); }
      float higher = 0.f;
      float a[16];
#pragma unroll
      for (int g = 3; g >= 0; --g) {
        const float base = carry + higher + (h == 0 ? Go[g] : 0.f);
        const float c3 = base + L[4 * g + 3];
        const float c2 = c3 + L[4 * g + 2];
        const float c1 = c2 + L[4 * g + 1];
        const float c0 = c1 + L[4 * g];
        const float cc[4] = {c0, c1, c2, c3};
#pragma unroll
        for (int rr = 0; rr < 4; ++rr) {
          const int e = 4 * g + rr;
          const bool valid = (kbase + crow(e, h)) < tq;
          a[e] = valid ? __expf(z[e] + cc[rr]) : 0.f;
        }
        higher += G[g] + Go[g];
      }
      carry += higher;
#pragma unroll
      for (int s2 = 0; s2 < 2; ++s2) {
        u32x4 pk;
#pragma unroll
        for (int j = 0; j < 4; ++j) pk[j] = pack2(a[8 * s2 + 2 * j], a[8 * s2 + 2 * j + 1]);
        const bf16x8 pf = __builtin_bit_cast(bf16x8, pk);
#pragma unroll
        for (int db = 0; db < 2; ++db) {
          const char* vrow = sV + (32 * db + r) * SROW + (32 * sub + 16 * s2 + 4 * h) * 2;
          const s16x4 lo = *(const s16x4*)(vrow);
          const s16x4 hi = *(const s16x4*)(vrow + 16);
          const bf16x8 vf = __builtin_shufflevector(lo, hi, 0, 1, 2, 3, 4, 5, 6, 7);
          o[db] = MFMA32(vf, pf, o[db]);
        }
      }
    }
#if SB_EARLY
    if (__syncthreads_and(carry < -60.0f)) break;
#endif
  }
#pragma unroll
  for (int db = 0; db < 2; ++db)
#pragma unroll
    for (int g = 0; g < 4; ++g) {
      u32x2 ov; ov[0] = pack2(o[db][4 * g], o[db][4 * g + 1]); ov[1] = pack2(o[db][4 * g + 2], o[db][4 * g + 3]);
      *(u32x2*)(Y + (size_t)(b * SEQ + tq) * 1024 + hd * 64 + 32 * db + 8 * g + 4 * h) = ov;
    }
}

DI unsigned sortable(float v) {
  v = v + 0.0f;
  const unsigned u = __float_as_uint(v);
  return (u & 0x80000000u) ? ~u : (u | 0x80000000u);
}

DI void mixB_item(const Params& p, int item, char* smem) {
  const bf16_t* qb = (const bf16_t*)(p.ws + OFF_QB); const bf16_t* kb = (const bf16_t*)(p.ws + OFF_KB);
  const bf16_t* vb = (const bf16_t*)(p.ws + OFF_VB); const bf16_t* qi = (const bf16_t*)(p.ws + OFF_QI);
  const bf16_t* ki = (const bf16_t*)(p.ws + OFF_KI); const float* wi = (const float*)(p.ws + OFF_WI);
  bf16_t* Y = (bf16_t*)(p.ws + OFF_Y);
  float* slab = (float*)(p.ws + OFF_HBUF) + (size_t)blockIdx.x * 8 * 4096;
  const int tid = otid(), lane = tid & 63, w = __builtin_amdgcn_readfirstlane(tid >> 6);
  const int l15 = lane & 15, l4 = lane >> 4;
  int* sidx0 = (int*)(smem + w * 6144);
  float* spl = (float*)(smem + w * 6144 + 2048);
  const int token0 = item * 8;
  const int b = token0 >> 12, pos0 = token0 & 4095, qc = pos0 >> 6;
  const int nkeys = (qc + 1) * 64, nk64 = qc + 1;
  {
    bf16x8 af[8];
#pragma unroll
    for (int hh = 0; hh < 8; ++hh) af[hh] = *(const bf16x8*)(qi + (size_t)(token0 + (lane & 7)) * 256 + hh * 32 + 8 * l4);
    float wq[4][8];
#pragma unroll
    for (int i = 0; i < 4; ++i)
#pragma unroll
      for (int hh = 0; hh < 8; ++hh) wq[i][hh] = wi[(size_t)(token0 + ((4 * l4 + i) & 7)) * 8 + hh];
    const int nkt_pad = ((nk64 + 3) & ~3) * 4;
    for (int kt = w; kt < nkt_pad; kt += 4) {
      const bf16x8 bfr = *(const bf16x8*)(ki + (size_t)(b * SEQ + kt * 16 + l15) * 32 + 8 * l4);
      float sc[4] = {0.f, 0.f, 0.f, 0.f};
#pragma unroll
      for (int hh = 0; hh < 8; ++hh) {
        f32x4 ac = {0.f, 0.f, 0.f, 0.f};
        ac = MFMA16(af[hh], bfr, ac);
#pragma unroll
        for (int i = 0; i < 4; ++i) sc[i] += wq[i][hh] * fmaxf(ac[i], 0.f);
      }
      if (l4 < 2) {
        const bool adm = kt * 16 < nkeys;
#pragma unroll
        for (int i = 0; i < 4; ++i) slab[(size_t)(4 * l4 + i) * 4096 + kt * 16 + l15] = adm ? sc[i] : -INFINITY;
      }
    }
  }
  __threadfence();
  __syncthreads();
  const int cntsel = nkeys <= 256 ? nkeys : 256;
#pragma unroll 1
  for (int qq = 0; qq < 2; ++qq) {
    const int q = 2 * w + qq;
    int* sidx = sidx0 + qq * 256;
    if (nkeys <= 256) {
      for (int s = lane; s < 256; s += 64) sidx[s] = (s < nkeys) ? s : 0;
    } else {
      const float* srow = slab + (size_t)q * 4096;
      unsigned u[64];
#pragma unroll
      for (int i = 0; i < 64; ++i) u[i] = 0u;
#pragma unroll
      for (int c = 0; c < 16; ++c) {
        if (c * 4 < nk64) {
#pragma unroll
          for (int i = c * 4; i < c * 4 + 4; ++i)
            u[i] = sortable(__hip_atomic_load(srow + i * 64 + lane, __ATOMIC_RELAXED, __HIP_MEMORY_SCOPE_AGENT));
        }
      }
      unsigned thr = 0u;
      for (int bit = 31; bit >= 0; --bit) {
        const unsigned cand = thr | (1u << bit);
        int cnt = 0;
#pragma unroll
        for (int c = 0; c < 4; ++c) {
          if (c * 16 < nk64) {
#pragma unroll
            for (int i = c * 16; i < c * 16 + 16; ++i) cnt += __builtin_popcountll(__ballot(u[i] >= cand));
          }
        }
        if (cnt >= 256) thr = cand;
      }
      int bgt = 0;
#pragma unroll
      for (int i = 0; i < 64; ++i) {
        const unsigned long long mgt = __ballot(u[i] > thr);
        const int pre = __builtin_amdgcn_mbcnt_hi((unsigned)(mgt >> 32), __builtin_amdgcn_mbcnt_lo((unsigned)mgt, 0u));
        if (u[i] > thr) sidx[bgt + pre] = i * 64 + lane;
        bgt += __builtin_popcountll(mgt);
      }
      int beq = bgt;
#pragma unroll
      for (int i = 0; i < 64; ++i) {
        const unsigned long long meq = __ballot(u[i] == thr);
        const int pos = beq + __builtin_amdgcn_mbcnt_hi((unsigned)(meq >> 32), __builtin_amdgcn_mbcnt_lo((unsigned)meq, 0u));
        if (u[i] == thr && pos < 256) sidx[pos] = i * 64 + lane;
        beq += __builtin_popcountll(meq);
      }
    }
  }
  __syncthreads();
#pragma unroll 1
  for (int qq = 0; qq < 2; ++qq) {
    const int token = token0 + 2 * w + qq;
    const int* sidx = sidx0 + qq * 256;
#pragma unroll 1
    for (int g = 0; g < 2; ++g) {
      bf16x8 qf0, qf1;
      {
        const bf16_t* qp = qb + (size_t)token * 512 + (g * 4 + (lane & 3)) * 64 + 8 * l4;
        qf0 = *(const bf16x8*)qp; qf1 = *(const bf16x8*)(qp + 32);
      }
      float mx[4] = {-INFINITY, -INFINITY, -INFINITY, -INFINITY};
#pragma unroll
      for (int t = 0; t < 16; ++t) {
        const int key = sidx[t * 16 + l15];
        const bf16_t* kp = kb + (size_t)(b * SEQ + key) * 128 + g * 64 + 8 * l4;
        const bf16x8 k0 = *(const bf16x8*)kp; const bf16x8 k1 = *(const bf16x8*)(kp + 32);
        f32x4 ac = {0.f, 0.f, 0.f, 0.f};
        ac = MFMA16(qf0, k0, ac);
        ac = MFMA16(qf1, k1, ac);
        const bool ok = (t * 16 + l15) < cntsel;
        f32x4 lgv;
#pragma unroll
        for (int i = 0; i < 4; ++i) { lgv[i] = ok ? ac[i] * 0.125f : -INFINITY; mx[i] = fmaxf(mx[i], lgv[i]); }
        if (l4 == (t & 3)) *(f32x4*)(spl + (t * 16 + l15) * 4) = lgv;
        if ((t & 3) == 3) __builtin_amdgcn_sched_barrier(0);
      }
#pragma unroll
      for (int i = 0; i < 4; ++i) {
#pragma unroll
        for (int o = 1; o < 16; o <<= 1) mx[i] = fmaxf(mx[i], __shfl_xor(mx[i], o));
      }
      __syncthreads();
      float sm[4] = {0.f, 0.f, 0.f, 0.f};
#pragma unroll
      for (int jj = 0; jj < 4; ++jj) {
        f32x4 pv = *(const f32x4*)(spl + (jj * 64 + lane) * 4);
#pragma unroll
        for (int i = 0; i < 4; ++i) { pv[i] = __expf(pv[i] - mx[i]); sm[i] += pv[i]; }
        *(f32x4*)(spl + (jj * 64 + lane) * 4) = pv;
      }
#pragma unroll
      for (int i = 0; i < 4; ++i) {
#pragma unroll
        for (int o = 1; o < 64; o <<= 1) sm[i] += __shfl_xor(sm[i], o);
      }
      __syncthreads();
      const int dp = lane & 31, hh2 = lane >> 5;
      float ao[4][2];
#pragma unroll
      for (int i = 0; i < 4; ++i) { ao[i][0] = 0.f; ao[i][1] = 0.f; }
      const bf16_t* vbase = vb + (size_t)b * SEQ * 128 + g * 64 + 2 * dp;
#pragma unroll 8
      for (int kk = 0; kk < 128; ++kk) {
        const int slot = 2 * kk + hh2;
        const int key = sidx[slot];
        const f32x4 pv = *(const f32x4*)(spl + slot * 4);
        const unsigned v2 = *(const unsigned*)(vbase + (size_t)key * 128);
        const float vlo = __uint_as_float(v2 << 16), vhi = __uint_as_float(v2 & 0xffff0000u);
#pragma unroll
        for (int i = 0; i < 4; ++i) { ao[i][0] += pv[i] * vlo; ao[i][1] += pv[i] * vhi; }
      }
#pragma unroll
      for (int i = 0; i < 4; ++i) {
        ao[i][0] += __shfl_xor(ao[i][0], 32); ao[i][1] += __shfl_xor(ao[i][1], 32);
        const float inv = 1.0f / sm[i];
        if (hh2 == 0) *(unsigned*)(Y + (size_t)token * 1024 + 512 + (g * 4 + i) * 64 + 2 * dp) = pack2(ao[i][0] * inv, ao[i][1] * inv);
      }
      __syncthreads();
    }
  }
}

DI void phase_mixers(const Params& p, char* smem) {
  constexpr int NA = 2048, NB = 4096;
  for (int it = blockIdx.x; it < NA + NB; it += gridDim.x) {
    if (it < NA) mixA_item(p, it, smem);
    else mixB_item(p, it - NA, smem);
    __syncthreads();
  }
}

DI void phase_merge(const Params& p, int layer, char* smem) {
  const bf16_t* Y = (const bf16_t*)(p.ws + OFF_Y);
  const bf16_t* Wa = (const bf16_t*)(p.ws + (size_t)layer * WT_LAYER + WT_UPA);
  const bf16_t* Wb = (const bf16_t*)(p.ws + (size_t)layer * WT_LAYER + WT_UPB);
  const bf16_t* gates = (const bf16_t*)(p.ws + OFF_GATES);
  bf16_t* mg = (bf16_t*)(p.ws + OFF_HBUF);
  const int tid_ = otid(); const int lane = tid_ & 63, wave = tid_ >> 6;
  const int wm = wave >> 1, wn = wave & 1, r = lane & 31, h = lane >> 5;
  constexpr int MT = T_TOK / 128, NT = 8;
  for (int idx = blockIdx.x; idx < MT * NT; idx += gridDim.x) {
    int mi, ni; tile_coord(idx, NT, mi, ni);
    f32x16 acc[2][2];
    zero_acc(acc);
    gemm_tile(Y + 512, 1024, Wb, 512, 512, mi * 128, ni * 128, acc, smem);
#pragma unroll
    for (int i = 0; i < 2; ++i)
#pragma unroll
      for (int j = 0; j < 2; ++j)
#pragma unroll
        for (int g = 0; g < 4; ++g) {
          const int row = mi * 128 + wm * 64 + i * 32 + 8 * g + 4 * h, col = ni * 128 + wn * 64 + j * 32 + r;
          const u32x2 ga2 = *(const u32x2*)(gates + ((size_t)(row >> 2) * 2048 + col) * 4);
          const u32x2 gb2 = *(const u32x2*)(gates + ((size_t)(row >> 2) * 2048 + 1024 + col) * 4);
#pragma unroll
          for (int rr = 0; rr < 4; ++rr) {
            const unsigned wa = ga2[rr >> 1], wb = gb2[rr >> 1];
            const float ga = fmaxf((rr & 1) ? __uint_as_float(wa & 0xffff0000u) : __uint_as_float(wa << 16), 1e-20f);
            const float gb = (rr & 1) ? __uint_as_float(wb & 0xffff0000u) : __uint_as_float(wb << 16);
            acc[i][j][4 * g + rr] *= gb / ga;
          }
        }
    gemm_tile(Y, 1024, Wa, 512, 512, mi * 128, ni * 128, acc, smem);
#pragma unroll
    for (int i = 0; i < 2; ++i)
#pragma unroll
      for (int j = 0; j < 2; ++j)
#pragma unroll
        for (int g = 0; g < 4; ++g) {
          const int row = mi * 128 + wm * 64 + i * 32 + 8 * g + 4 * h, col = ni * 128 + wn * 64 + j * 32 + r;
          const u32x2 ga2 = *(const u32x2*)(gates + ((size_t)(row >> 2) * 2048 + col) * 4);
#pragma unroll
          for (int rr = 0; rr < 4; ++rr) {
            const unsigned wa = ga2[rr >> 1];
            const float ga = fmaxf((rr & 1) ? __uint_as_float(wa & 0xffff0000u) : __uint_as_float(wa << 16), 1e-20f);
            mg[(size_t)(row + rr) * 1024 + col] = f2bf(acc[i][j][4 * g + rr] * ga);
          }
        }
  }
}

DI void phase_gemm_resid(const bf16_t* A, int lda, const bf16_t* Bt, int K, const float* resid, float* out, char* smem) {
  const int tid_ = otid(); const int lane = tid_ & 63, wave = tid_ >> 6;
  const int wm = wave >> 1, wn = wave & 1, r = lane & 31, h = lane >> 5;
  constexpr int MT = T_TOK / 128, NT = 8;
  for (int idx = blockIdx.x; idx < MT * NT; idx += gridDim.x) {
    int mi, ni; tile_coord(idx, NT, mi, ni);
    f32x16 acc[2][2]; zero_acc(acc);
    gemm_tile(A, lda, Bt, K, K, mi * 128, ni * 128, acc, smem);
#pragma unroll
    for (int i = 0; i < 2; ++i)
#pragma unroll
      for (int j = 0; j < 2; ++j)
#pragma unroll
        for (int e = 0; e < 16; ++e) {
          const size_t off = (size_t)(mi * 128 + wm * 64 + i * 32 + crow(e, h)) * 1024 + ni * 128 + wn * 64 + j * 32 + r;
          out[off] = resid[off] + acc[i][j][e];
        }
  }
}

DI void phase_ff1(const Params& p, int layer, char* smem) {
  const bf16_t* A = (const bf16_t*)(p.ws + OFF_HBUF);
  const bf16_t* Bt = (const bf16_t*)(p.ws + (size_t)layer * WT_LAYER + WT_FF1);
  bf16_t* hid = (bf16_t*)(p.ws + OFF_HIDDEN);
  const int tid_ = otid(); const int lane = tid_ & 63, wave = tid_ >> 6;
  const int wm = wave >> 1, wn = wave & 1, r = lane & 31, h = lane >> 5;
  constexpr int MT = T_TOK / 128, NT = 32;
  for (int idx = blockIdx.x; idx < MT * NT; idx += gridDim.x) {
    int mi, ni; tile_coord(idx, NT, mi, ni);
    f32x16 acc[2][2]; zero_acc(acc);
    gemm_tile(A, 1024, Bt, 1024, 1024, mi * 128, ni * 128, acc, smem);
#pragma unroll
    for (int i = 0; i < 2; ++i)
#pragma unroll
      for (int j = 0; j < 2; ++j)
#pragma unroll
        for (int e = 0; e < 16; ++e) {
          const float v = fmaxf(acc[i][j][e], 0.f);
          hid[(size_t)(mi * 128 + wm * 64 + i * 32 + crow(e, h)) * 4096 + ni * 128 + wn * 64 + j * 32 + r] = f2bf(v * v);
        }
  }
}

__global__ void __launch_bounds__(256, 2) fwd_megakernel(Params p) {
  cg::grid_group grid = cg::this_grid();
  __shared__ __attribute__((aligned(16))) char smem[2 * 128 * SROW];
  phase_prep(p, smem);
  grid.sync();
#pragma unroll 1
  for (int layer = 0; layer < 2; ++layer) {
    const float* xin = layer == 0 ? p.x : p.out;
    phase_rmsnorm<false>(xin, p.g_mix + layer * DM, (bf16_t*)(p.ws + OFF_HBUF), nullptr);
    grid.sync();
    phase_inproj(p, layer, smem);
    grid.sync();
    phase_mixers(p, smem);
    grid.sync();
    phase_merge(p, layer, smem);
    grid.sync();
    phase_gemm_resid((const bf16_t*)(p.ws + OFF_HBUF), 1024, (const bf16_t*)(p.ws + (size_t)layer * WT_LAYER + WT_O), 1024, xin, p.out, smem);
    grid.sync();
    phase_rmsnorm<false>(p.out, p.g_mlp + layer * DM, (bf16_t*)(p.ws + OFF_HBUF), nullptr);
    grid.sync();
    phase_ff1(p, layer, smem);
    grid.sync();
    phase_gemm_resid((const bf16_t*)(p.ws + OFF_HIDDEN), 4096, (const bf16_t*)(p.ws + (size_t)layer * WT_LAYER + WT_FF2), 4096, p.out, p.out, smem);
    grid.sync();
  }
  phase_rmsnorm<true>(p.out, p.g_final, nullptr, p.out);
}

extern "C" void kernel_launch(void* const* d_in, const int* in_sizes, int n_in,
                              void* d_out, int out_size, void* d_ws, size_t ws_size,
                              hipStream_t stream) {
  static int grid_blocks = 0;
  if (!grid_blocks) {
    int dev = 0, cus = 0, per_cu = 0;
    (void)hipGetDevice(&dev);
    (void)hipDeviceGetAttribute(&cus, hipDeviceAttributeMultiprocessorCount, dev);
    (void)hipOccupancyMaxActiveBlocksPerMultiprocessor(&per_cu, fwd_megakernel, 256, 0);
    if (per_cu > 2) per_cu = 2;
    if (per_cu < 1) per_cu = 1;
    grid_blocks = cus * per_cu;
  }
  Params p{};
  p.x = (const float*)d_in[0]; p.g_mix = (const float*)d_in[1]; p.w_in = (const float*)d_in[2];
  p.w_up_a = (const float*)d_in[3]; p.w_up_b = (const float*)d_in[4]; p.w_o = (const float*)d_in[5];
  p.g_mlp = (const float*)d_in[6]; p.w_ff1 = (const float*)d_in[7]; p.w_ff2 = (const float*)d_in[8];
  p.g_final = (const float*)d_in[9];
  p.out = (float*)d_out; p.ws = (char*)d_ws;
  void* args[] = {&p};
  hipError_t e = hipLaunchCooperativeKernel((void*)fwd_megakernel, dim3(grid_blocks), dim3(256), args, 0, stream);
  if (e != hipSuccess) fprintf(stderr, "cooperative launch failed: %s (grid %d)\n", hipGetErrorString(e), grid_blocks);
}
```

```cpp
#include <hip/hip_runtime.h>
#include <hip/hip_bf16.h>
#include <hip/hip_cooperative_groups.h>
#include <cstdio>
namespace cg = cooperative_groups;

#define DI __device__ __forceinline__
typedef unsigned short bf16_t;
typedef __bf16 bf2_t __attribute__((ext_vector_type(2)));
typedef float fl2_t __attribute__((ext_vector_type(2)));
using bf16x8 = __attribute__((ext_vector_type(8))) short;
using s16x4  = __attribute__((ext_vector_type(4))) short;
using f32x16 = __attribute__((ext_vector_type(16))) float;
using f32x4  = __attribute__((ext_vector_type(4))) float;
using u32x4  = __attribute__((ext_vector_type(4))) unsigned;
using u32x2  = __attribute__((ext_vector_type(2))) unsigned;

#define MFMA32(a, b, c) __builtin_amdgcn_mfma_f32_32x32x16_bf16((a), (b), (c), 0, 0, 0)
#define MFMA16(a, b, c) __builtin_amdgcn_mfma_f32_16x16x32_bf16((a), (b), (c), 0, 0, 0)

#ifndef SB_EARLY
#define SB_EARLY 1
#endif

constexpr int T_TOK = 32768, SEQ = 4096, DM = 1024;
constexpr int NPAD_IN = 4736;
constexpr int SROW = 144;

constexpr size_t WT_IN = 0;
constexpr size_t WT_UPA = WT_IN + (size_t)NPAD_IN * 1024 * 2;
constexpr size_t WT_UPB = WT_UPA + (size_t)1024 * 512 * 2;
constexpr size_t WT_O   = WT_UPB + (size_t)1024 * 512 * 2;
constexpr size_t WT_FF1 = WT_O + (size_t)1024 * 1024 * 2;
constexpr size_t WT_FF2 = WT_FF1 + (size_t)4096 * 1024 * 2;
constexpr size_t WT_LAYER = WT_FF2 + (size_t)1024 * 4096 * 2;
constexpr size_t OFF_ROPE = 2 * WT_LAYER;
constexpr size_t OFF_QA = OFF_ROPE + (size_t)SEQ * 24 * 4;
constexpr size_t OFF_KA = OFF_QA + (size_t)T_TOK * 512 * 2;
constexpr size_t OFF_VAT = OFF_KA + (size_t)T_TOK * 512 * 2;
constexpr size_t OFF_QB = OFF_VAT + (size_t)T_TOK * 512 * 2;
constexpr size_t OFF_KB = OFF_QB + (size_t)T_TOK * 512 * 2;
constexpr size_t OFF_VB = OFF_KB + (size_t)T_TOK * 128 * 2;
constexpr size_t OFF_QI = OFF_VB + (size_t)T_TOK * 128 * 2;
constexpr size_t OFF_KI = OFF_QI + (size_t)T_TOK * 256 * 2;
constexpr size_t OFF_WI = OFF_KI + (size_t)T_TOK * 32 * 2;
constexpr size_t OFF_GATES = OFF_WI + (size_t)T_TOK * 8 * 4;
constexpr size_t OFF_PROJ_END = OFF_GATES + (size_t)T_TOK * 2048 * 2;
constexpr size_t OFF_HIDDEN = OFF_QA;
constexpr size_t OFF_Y = OFF_PROJ_END;
constexpr size_t OFF_HBUF = OFF_Y + (size_t)T_TOK * 1024 * 2;
constexpr size_t OFF_END = OFF_HBUF + (size_t)T_TOK * 1024 * 2;
static_assert(OFF_END <= (size_t)512 * 1024 * 1024, "workspace too large");
static_assert(OFF_HIDDEN + (size_t)T_TOK * 4096 * 2 <= OFF_PROJ_END, "hidden alias");

struct Params {
  const float* x; const float* g_mix; const float* w_in; const float* w_up_a; const float* w_up_b;
  const float* w_o; const float* g_mlp; const float* w_ff1; const float* w_ff2; const float* g_final;
  float* out; char* ws;
};

DI unsigned pack2(float a, float b) {
  fl2_t f = {a, b};
  bf2_t r = __builtin_convertvector(f, bf2_t);
  return __builtin_bit_cast(unsigned, r);
}
DI bf16_t f2bf(float a) { return (bf16_t)(pack2(a, 0.f) & 0xffffu); }
DI float bf2f(unsigned short v) { return __uint_as_float(((unsigned)v) << 16); }
DI int crow(int reg, int h) { return (reg & 3) + 8 * (reg >> 2) + 4 * h; }
DI int otid() { int t = threadIdx.x; asm volatile("" : "+v"(t)); return t; }

DI int src_col(int nd, int mode) {
  if (!mode) return nd;
  if (nd < 2560) return nd;
  if (nd < 4608) return nd + 40;
  if (nd < 4648) return nd - 2048;
  return -1;
}
DI void convT(const float* __restrict__ W, int K, int N, bf16_t* __restrict__ WT, int NR, int mode, char* smem) {
  float* tile = (float*)smem;
  const int tid = otid();
  const int kt_n = K / 64, nt_n = NR / 64;
  for (int t = blockIdx.x; t < kt_n * nt_n; t += gridDim.x) {
    const int k0 = (t % kt_n) * 64, n0 = (t / kt_n) * 64;
    const int nl = tid & 63;
    const int sc = src_col(n0 + nl, mode);
    __syncthreads();
#pragma unroll
    for (int r = 0; r < 16; ++r) {
      const int kl = r * 4 + (tid >> 6);
      float v = 0.f;
      if (sc >= 0) v = W[(size_t)(k0 + kl) * N + sc];
      tile[kl * 65 + nl] = v;
    }
    __syncthreads();
    const int nrow = tid >> 2, ks = (tid & 3) * 16;
    u32x4 o0, o1;
#pragma unroll
    for (int j = 0; j < 4; ++j) {
      o0[j] = pack2(tile[(ks + 2 * j) * 65 + nrow], tile[(ks + 2 * j + 1) * 65 + nrow]);
      o1[j] = pack2(tile[(ks + 8 + 2 * j) * 65 + nrow], tile[(ks + 8 + 2 * j + 1) * 65 + nrow]);
    }
    bf16_t* dst = WT + (size_t)(n0 + nrow) * K + k0 + ks;
    *(u32x4*)dst = o0;
    *(u32x4*)(dst + 8) = o1;
  }
}

DI void phase_prep(const Params& p, char* smem) {
  for (int l = 0; l < 2; ++l) {
    char* wl = p.ws + (size_t)l * WT_LAYER;
    convT(p.w_in + (size_t)l * 1024 * 4648, 1024, 4648, (bf16_t*)(wl + WT_IN), NPAD_IN, 1, smem);
    convT(p.w_up_a + (size_t)l * 512 * 1024, 512, 1024, (bf16_t*)(wl + WT_UPA), 1024, 0, smem);
    convT(p.w_up_b + (size_t)l * 512 * 1024, 512, 1024, (bf16_t*)(wl + WT_UPB), 1024, 0, smem);
    convT(p.w_o + (size_t)l * 1024 * 1024, 1024, 1024, (bf16_t*)(wl + WT_O), 1024, 0, smem);
    convT(p.w_ff1 + (size_t)l * 1024 * 4096, 1024, 4096, (bf16_t*)(wl + WT_FF1), 4096, 0, smem);
    convT(p.w_ff2 + (size_t)l * 4096 * 1024, 4096, 1024, (bf16_t*)(wl + WT_FF2), 1024, 0, smem);
  }
  float* rope = (float*)(p.ws + OFF_ROPE);
  for (int i = blockIdx.x * 256 + threadIdx.x; i < SEQ * 12; i += gridDim.x * 256) {
    const int pos = i / 12, f = i % 12;
    float inv; int co, so;
    if (f < 8) { inv = powf(500000.0f, -((float)(2 * f) / 16.0f)); co = f; so = 8 + f; }
    else { inv = powf(500000.0f, -((float)(2 * (f - 8)) / 8.0f)); co = 16 + (f - 8); so = 20 + (f - 8); }
    const float ang = (float)pos * inv;
    float s, c; sincosf(ang, &s, &c);
    rope[pos * 24 + co] = c; rope[pos * 24 + so] = s;
  }
}

template <bool FINAL>
DI void phase_rmsnorm(const float* __restrict__ xin, const float* __restrict__ g, bf16_t* __restrict__ hout, float* __restrict__ fout) {
  const int tid_ = otid(); const int wave = tid_ >> 6, lane = tid_ & 63;
  for (int t = blockIdx.x * 4 + wave; t < T_TOK; t += gridDim.x * 4) {
    const float4* src = (const float4*)(xin + (size_t)t * DM);
    float4 v[4]; float ss = 0.f;
#pragma unroll
    for (int i = 0; i < 4; ++i) { v[i] = src[lane + 64 * i]; ss += v[i].x * v[i].x + v[i].y * v[i].y + v[i].z * v[i].z + v[i].w * v[i].w; }
#pragma unroll
    for (int o = 32; o > 0; o >>= 1) ss += __shfl_xor(ss, o);
    const float r = rsqrtf(ss * (1.0f / DM) + 1e-6f);
#pragma unroll
    for (int i = 0; i < 4; ++i) {
      const float4 gg = ((const float4*)g)[lane + 64 * i];
      const float a = v[i].x * r * gg.x, b = v[i].y * r * gg.y, c = v[i].z * r * gg.z, d = v[i].w * r * gg.w;
      if (FINAL) { float4 o4; o4.x = a; o4.y = b; o4.z = c; o4.w = d; ((float4*)(fout + (size_t)t * DM))[lane + 64 * i] = o4; }
      else { u32x2 o2; o2[0] = pack2(a, b); o2[1] = pack2(c, d); *(u32x2*)(hout + (size_t)t * DM + (lane + 64 * i) * 4) = o2; }
    }
  }
}

DI void gemm_tile(const bf16_t* __restrict__ A, int lda, const bf16_t* __restrict__ Bt, int ldb, int K, int m0, int n0,
                  f32x16 (&acc)[2][2], char* smem) {
  char* sA = smem; char* sB = smem + 128 * SROW;
  const int tid = otid(), lane = tid & 63, wave = tid >> 6;
  const int wm = wave >> 1, wn = wave & 1, r = lane & 31, h = lane >> 5;
  u32x4 ra[4], rb[4];
  const int lrow = tid >> 3, lkc = tid & 7;
  const bf16_t* ga = A + (size_t)(m0 + lrow) * lda + lkc * 8;
  const bf16_t* gb = Bt + (size_t)(n0 + lrow) * ldb + lkc * 8;
#pragma unroll
  for (int c = 0; c < 4; ++c) { ra[c] = *(const u32x4*)(ga + (size_t)(32 * c) * lda); rb[c] = *(const u32x4*)(gb + (size_t)(32 * c) * ldb); }
  const int KT = K / 64;
  for (int kt = 0; kt < KT; ++kt) {
    __syncthreads();
#pragma unroll
    for (int c = 0; c < 4; ++c) {
      *(u32x4*)(sA + (lrow + 32 * c) * SROW + lkc * 16) = ra[c];
      *(u32x4*)(sB + (lrow + 32 * c) * SROW + lkc * 16) = rb[c];
    }
    __syncthreads();
    if (kt + 1 < KT) {
      const int k0 = (kt + 1) * 64;
#pragma unroll
      for (int c = 0; c < 4; ++c) { ra[c] = *(const u32x4*)(ga + (size_t)(32 * c) * lda + k0); rb[c] = *(const u32x4*)(gb + (size_t)(32 * c) * ldb + k0); }
    }
#pragma unroll
    for (int ks = 0; ks < 4; ++ks) {
      const int ko = (ks * 16 + 8 * h) * 2;
      const bf16x8 a0 = *(const bf16x8*)(sA + (wm * 64 + r) * SROW + ko);
      const bf16x8 a1 = *(const bf16x8*)(sA + (wm * 64 + 32 + r) * SROW + ko);
      const bf16x8 b0 = *(const bf16x8*)(sB + (wn * 64 + r) * SROW + ko);
      const bf16x8 b1 = *(const bf16x8*)(sB + (wn * 64 + 32 + r) * SROW + ko);
      acc[0][0] = MFMA32(a0, b0, acc[0][0]);
      acc[0][1] = MFMA32(a0, b1, acc[0][1]);
      acc[1][0] = MFMA32(a1, b0, acc[1][0]);
      acc[1][1] = MFMA32(a1, b1, acc[1][1]);
    }
  }
}

DI void zero_acc(f32x16 (&acc)[2][2]) {
#pragma unroll
  for (int i = 0; i < 2; ++i)
#pragma unroll
    for (int j = 0; j < 2; ++j)
#pragma unroll
      for (int e = 0; e < 16; ++e) acc[i][j][e] = 0.f;
}

DI void tile_coord(int idx, int nt, int& mt_i, int& nt_i) {
  const int per = 16 * nt;
  const int grp = idx / per, rem = idx % per;
  nt_i = rem / 16; mt_i = grp * 16 + (rem % 16);
}

DI void phase_inproj(const Params& p, int layer, char* smem) {
  const bf16_t* A = (const bf16_t*)(p.ws + OFF_HBUF);
  const bf16_t* Bt = (const bf16_t*)(p.ws + (size_t)layer * WT_LAYER + WT_IN);
  const float* rope = (const float*)(p.ws + OFF_ROPE);
  bf16_t* qa = (bf16_t*)(p.ws + OFF_QA); bf16_t* ka = (bf16_t*)(p.ws + OFF_KA); bf16_t* vaT = (bf16_t*)(p.ws + OFF_VAT);
  bf16_t* qb = (bf16_t*)(p.ws + OFF_QB); bf16_t* kb = (bf16_t*)(p.ws + OFF_KB); bf16_t* vb = (bf16_t*)(p.ws + OFF_VB);
  bf16_t* qi = (bf16_t*)(p.ws + OFF_QI); bf16_t* ki = (bf16_t*)(p.ws + OFF_KI); float* wi = (float*)(p.ws + OFF_WI);
  bf16_t* gates = (bf16_t*)(p.ws + OFF_GATES);
  const int tid_ = otid(); const int lane = tid_ & 63, wave = tid_ >> 6;
  const int wm = wave >> 1, wn = wave & 1, r = lane & 31, h = lane >> 5;
  constexpr int MT = T_TOK / 128, NT = NPAD_IN / 128;
  for (int idx = blockIdx.x; idx < MT * NT; idx += gridDim.x) {
    int mi, ni; tile_coord(idx, NT, mi, ni);
    f32x16 acc[2][2]; zero_acc(acc);
    gemm_tile(A, 1024, Bt, 1024, 1024, mi * 128, ni * 128, acc, smem);
#pragma unroll
    for (int i = 0; i < 2; ++i)
#pragma unroll
      for (int j = 0; j < 2; ++j) {
        const int cl = wn * 64 + j * 32 + r;
        const int mbase = mi * 128 + wm * 64 + i * 32;
        if (ni < 8) {
          bf16_t* dst = (ni < 4) ? qa : ka;
          const int c = (ni & 3) * 128 + cl;
#pragma unroll
          for (int e = 0; e < 16; ++e) dst[(size_t)(mbase + crow(e, h)) * 512 + c] = f2bf(acc[i][j][e]);
        } else if (ni < 12) {
          const int c = (ni - 8) * 128 + cl; const int hd = c >> 6, d = c & 63;
#pragma unroll
          for (int g = 0; g < 4; ++g) {
            const int tok = mbase + 8 * g + 4 * h; const int b = tok >> 12, pos = tok & 4095;
            u32x2 o; o[0] = pack2(acc[i][j][4 * g], acc[i][j][4 * g + 1]); o[1] = pack2(acc[i][j][4 * g + 2], acc[i][j][4 * g + 3]);
            *(u32x2*)(vaT + ((size_t)((b * 8 + hd) * 64 + d)) * SEQ + pos) = o;
          }
        } else if (ni < 17) {
          const int c = (ni < 16 ? (ni - 12) * 128 : 0) + cl; const int d = cl & 63;
          bf16_t* dst = (ni < 16) ? qb : kb; const int ld = (ni < 16) ? 512 : 128;
#pragma unroll
          for (int e = 0; e < 16; ++e) {
            const int tok = mbase + crow(e, h); const int pos = tok & 4095;
            float v = acc[i][j][e];
            const float pv = __shfl_xor(v, 8);
            if (d < 16) {
              const float cs = rope[pos * 24 + (d & 7)], sn = rope[pos * 24 + 8 + (d & 7)];
              v = (d < 8) ? (v * cs - pv * sn) : (v * cs + pv * sn);
            }
            dst[(size_t)tok * ld + c] = f2bf(v);
          }
        } else if (ni == 17) {
#pragma unroll
          for (int e = 0; e < 16; ++e) vb[(size_t)(mbase + crow(e, h)) * 128 + cl] = f2bf(acc[i][j][e]);
        } else if (ni < 20) {
          const int c = (ni - 18) * 128 + cl; const int d = cl & 31;
#pragma unroll
          for (int e = 0; e < 16; ++e) {
            const int tok = mbase + crow(e, h); const int pos = tok & 4095;
            float v = acc[i][j][e];
            const float pv = __shfl_xor(v, 4);
            if (d < 8) {
              const float cs = rope[pos * 24 + 16 + (d & 3)], sn = rope[pos * 24 + 20 + (d & 3)];
              v = (d < 4) ? (v * cs - pv * sn) : (v * cs + pv * sn);
            }
            qi[(size_t)tok * 256 + c] = f2bf(v);
          }
        } else if (ni < 36) {
          const int c = (ni - 20) * 128 + cl;
#pragma unroll
          for (int g = 0; g < 4; ++g) {
            float sg[4];
#pragma unroll
            for (int rr = 0; rr < 4; ++rr) sg[rr] = 1.0f / (1.0f + __expf(-acc[i][j][4 * g + rr]));
            u32x2 o; o[0] = pack2(sg[0], sg[1]); o[1] = pack2(sg[2], sg[3]);
            *(u32x2*)(gates + ((size_t)((mbase + 8 * g + 4 * h) >> 2) * 2048 + c) * 4) = o;
          }
        } else {
#pragma unroll
          for (int e = 0; e < 16; ++e) {
            const int tok = mbase + crow(e, h); const int pos = tok & 4095;
            float v = acc[i][j][e];
            const float pv = __shfl_xor(v, 4);
            if (cl < 32) {
              if (cl < 8) {
                const float cs = rope[pos * 24 + 16 + (cl & 3)], sn = rope[pos * 24 + 20 + (cl & 3)];
                v = (cl < 4) ? (v * cs - pv * sn) : (v * cs + pv * sn);
              }
              ki[(size_t)tok * 32 + cl] = f2bf(v);
            } else if (cl < 40) {
              wi[(size_t)tok * 8 + (cl - 32)] = v * 0.0625f;
            }
          }
        }
      }
  }
}

DI void mixA_item(const Params& p, int item, char* smem) {
  const bf16_t* qa = (const bf16_t*)(p.ws + OFF_QA); const bf16_t* ka = (const bf16_t*)(p.ws + OFF_KA);
  const bf16_t* vaT = (const bf16_t*)(p.ws + OFF_VAT); bf16_t* Y = (bf16_t*)(p.ws + OFF_Y);
  char* sK = smem; char* sV = smem + 64 * SROW;
  const int tid = otid(), lane = tid & 63, w = tid >> 6, r = lane & 31, h = lane >> 5;
  const int bh = item & 63, qblk = 31 - (item >> 6);
  const int b = bh >> 3, hd = bh & 7;
  const int q0 = qblk * 128;
  const int tq = q0 + 32 * w + r;
  bf16x8 qf[4];
#pragma unroll
  for (int s = 0; s < 4; ++s) qf[s] = *(const bf16x8*)(qa + (size_t)(b * SEQ + tq) * 512 + hd * 64 + 16 * s + 8 * h);
  f32x16 o[2];
#pragma unroll
  for (int e = 0; e < 16; ++e) { o[0][e] = 0.f; o[1][e] = 0.f; }
  float carry = 0.f;
  const int nkt = 2 * qblk + 2;
  const int lrow = tid >> 2, lc = (tid & 3) * 2;
  const bf16_t* gk = ka + (size_t)(b * SEQ + lrow) * 512 + hd * 64 + lc * 8;
  const bf16_t* gv = vaT + ((size_t)((b * 8 + hd) * 64 + lrow)) * SEQ + lc * 8;
  u32x4 rk0, rk1, rv0, rv1;
  {
    const int key0 = (nkt - 1) * 64;
    rk0 = *(const u32x4*)(gk + (size_t)key0 * 512); rk1 = *(const u32x4*)(gk + (size_t)key0 * 512 + 8);
    rv0 = *(const u32x4*)(gv + key0); rv1 = *(const u32x4*)(gv + key0 + 8);
  }
  for (int kt = nkt - 1; kt >= 0; --kt) {
    __syncthreads();
    *(u32x4*)(sK + lrow * SROW + lc * 16) = rk0; *(u32x4*)(sK + lrow * SROW + lc * 16 + 16) = rk1;
    *(u32x4*)(sV + lrow * SROW + lc * 16) = rv0; *(u32x4*)(sV + lrow * SROW + lc * 16 + 16) = rv1;
    __syncthreads();
    if (kt > 0) {
      const int key0 = (kt - 1) * 64;
      rk0 = *(const u32x4*)(gk + (size_t)key0 * 512); rk1 = *(const u32x4*)(gk + (size_t)key0 * 512 + 8);
      rv0 = *(const u32x4*)(gv + key0); rv1 = *(const u32x4*)(gv + key0 + 8);
    }
    const int wq_max = q0 + 32 * w + 31;
#pragma unroll
    for (int sub = 1; sub >= 0; --sub) {
      const int kbase = kt * 64 + 32 * sub;
      if (kbase >= wq_max) continue;
      f32x16 sacc;
#pragma unroll
      for (int e = 0; e < 16; ++e) sacc[e] = 0.f;
#pragma unroll
      for (int s = 0; s < 4; ++s) {
        const bf16x8 kf = *(const bf16x8*)(sK + (32 * sub + r) * SROW + (16 * s + 8 * h) * 2);
        sacc = MFMA32(kf, qf[s], sacc);
      }
      float z[16], L[16];
#pragma unroll
      for (int e = 0; e < 16; ++e) {
        z[e] = sacc[e] * 0.125f;
        const bool valid = (kbase + crow(e, h)) < tq;
        const float ex = __expf(-fabsf(z[e]));
        const float sp = fmaxf(z[e], 0.f) + __logf(1.0f + ex);
        L[e] = valid ? -sp : 0.f;
      }
      float G[4], Go[4];
#pragma unroll
      for (int g = 0; g < 4; ++g) { G[g] = (L[4 * g] + L[4 * g + 1]) + (L[4 * g + 2] + L[4 * g + 3]); Go[g] = __shfl_xor(G[g], 32); }
      float higher = 0.f;
      float a[16];
#pragma unroll
      for (int g = 3; g >= 0; --g) {
        const float base = carry + higher + (h == 0 ? Go[g] : 0.f);
        const float c3 = base + L[4 * g + 3];
        const float c2 = c3 + L[4 * g + 2];
        const float c1 = c2 + L[4 * g + 1];
        const float c0 = c1 + L[4 * g];
        const float cc[4] = {c0, c1, c2, c3};
#pragma unroll
        for (int rr = 0; rr < 4; ++rr) {
          const int e = 4 * g + rr;
          const bool valid = (kbase + crow(e, h)) < tq;
          a[e] = valid ? __expf(z[e] + cc[rr]) : 0.f;
        }
        higher += G[g] + Go[g];
      }
      carry += higher;
#pragma unroll
      for (int s2 = 0; s2 < 2; ++s2) {
        u32x4 pk;
#pragma unroll
        for (int j = 0; j < 4; ++j) pk[j] = pack2(a[8 * s2 + 2 * j], a[8 * s2 + 2 * j + 1]);
        const bf16x8 pf = __builtin_bit_cast(bf16x8, pk);
#pragma unroll
        for (int db = 0; db < 2; ++db) {
          const char* vrow = sV + (32 * db + r) * SROW + (32 * sub + 16 * s2 + 4 * h) * 2;
          const s16x4 lo = *(const s16x4*)(vrow);
          const s16x4 hi = *(const s16x4*)(vrow + 16);
          const bf16x8 vf = __builtin_shufflevector(lo, hi, 0, 1, 2, 3, 4, 5, 6, 7);
          o[db] = MFMA32(vf, pf, o[db]);
        }
      }
    }
#if SB_EARLY
    if (__syncthreads_and(carry < -60.0f)) break;
#endif
  }
#pragma unroll
  for (int db = 0; db < 2; ++db)
#pragma unroll
    for (int g = 0; g < 4; ++g) {
      u32x2 ov; ov[0] = pack2(o[db][4 * g], o[db][4 * g + 1]); ov[1] = pack2(o[db][4 * g + 2], o[db][4 * g + 3]);
      *(u32x2*)(Y + (size_t)(b * SEQ + tq) * 1024 + hd * 64 + 32 * db + 8 * g + 4 * h) = ov;
    }
}

DI unsigned sortable(float v) {
  v = v + 0.0f;
  const unsigned u = __float_as_uint(v);
  return (u & 0x80000000u) ? ~u : (u | 0x80000000u);
}

DI void mixB_item(const Params& p, int item, char* smem) {
  const bf16_t* qb = (const bf16_t*)(p.ws + OFF_QB); const bf16_t* kb = (const bf16_t*)(p.ws + OFF_KB);
  const bf16_t* vb = (const bf16_t*)(p.ws + OFF_VB); const bf16_t* qi = (const bf16_t*)(p.ws + OFF_QI);
  const bf16_t* ki = (const bf16_t*)(p.ws + OFF_KI); const float* wi = (const float*)(p.ws + OFF_WI);
  bf16_t* Y = (bf16_t*)(p.ws + OFF_Y);
  float* slab = (float*)(p.ws + OFF_HBUF) + (size_t)blockIdx.x * 8 * 4096;
  const int tid = otid(), lane = tid & 63, w = __builtin_amdgcn_readfirstlane(tid >> 6);
  const int l15 = lane & 15, l4 = lane >> 4;
  int* sidx0 = (int*)(smem + w * 6144);
  float* spl = (float*)(smem + w * 6144 + 2048);
  const int token0 = item * 8;
  const int b = token0 >> 12, pos0 = token0 & 4095, qc = pos0 >> 6;
  const int nkeys = (qc + 1) * 64, nk64 = qc + 1;
  {
    bf16x8 af[8];
#pragma unroll
    for (int hh = 0; hh < 8; ++hh) af[hh] = *(const bf16x8*)(qi + (size_t)(token0 + (lane & 7)) * 256 + hh * 32 + 8 * l4);
    float wq[4][8];
#pragma unroll
    for (int i = 0; i < 4; ++i)
#pragma unroll
      for (int hh = 0; hh < 8; ++hh) wq[i][hh] = wi[(size_t)(token0 + ((4 * l4 + i) & 7)) * 8 + hh];
    const int nkt_pad = ((nk64 + 3) & ~3) * 4;
    for (int kt = w; kt < nkt_pad; kt += 4) {
      const bf16x8 bfr = *(const bf16x8*)(ki + (size_t)(b * SEQ + kt * 16 + l15) * 32 + 8 * l4);
      float sc[4] = {0.f, 0.f, 0.f, 0.f};
#pragma unroll
      for (int hh = 0; hh < 8; ++hh) {
        f32x4 ac = {0.f, 0.f, 0.f, 0.f};
        ac = MFMA16(af[hh], bfr, ac);
#pragma unroll
        for (int i = 0; i < 4; ++i) sc[i] += wq[i][hh] * fmaxf(ac[i], 0.f);
      }
      if (l4 < 2) {
        const bool adm = kt * 16 < nkeys;
#pragma unroll
        for (int i = 0; i < 4; ++i) slab[(size_t)(4 * l4 + i) * 4096 + kt * 16 + l15] = adm ? sc[i] : -INFINITY;
      }
    }
  }
  __threadfence();
  __syncthreads();
  const int cntsel = nkeys <= 256 ? nkeys : 256;
#pragma unroll 1
  for (int qq = 0; qq < 2; ++qq) {
    const int q = 2 * w + qq;
    int* sidx = sidx0 + qq * 256;
    if (nkeys <= 256) {
      for (int s = lane; s < 256; s += 64) sidx[s] = (s < nkeys) ? s : 0;
    } else {
      const float* srow = slab + (size_t)q * 4096;
      unsigned u[64];
#pragma unroll
      for (int i = 0; i < 64; ++i) u[i] = 0u;
#pragma unroll
      for (int c = 0; c < 16; ++c) {
        if (c * 4 < nk64) {
#pragma unroll
          for (int i = c * 4; i < c * 4 + 4; ++i)
            u[i] = sortable(__hip_atomic_load(srow + i * 64 + lane, __ATOMIC_RELAXED, __HIP_MEMORY_SCOPE_AGENT));
        }
      }
      unsigned thr = 0u;
      for (int bit = 31; bit >= 0; --bit) {
        const unsigned cand = thr | (1u << bit);
        int cnt = 0;
#pragma unroll
        for (int c = 0; c < 4; ++c) {
          if (c * 16 < nk64) {
#pragma unroll
            for (int i = c * 16; i < c * 16 + 16; ++i) cnt += __builtin_popcountll(__ballot(u[i] >= cand));
          }
        }
        if (cnt >= 256) thr = cand;
      }
      int bgt = 0;
#pragma unroll
      for (int i = 0; i < 64; ++i) {
        const unsigned long long mgt = __ballot(u[i] > thr);
        const int pre = __builtin_amdgcn_mbcnt_hi((unsigned)(mgt >> 32), __builtin_amdgcn_mbcnt_lo((unsigned)mgt, 0u));
        if (u[i] > thr) sidx[bgt + pre] = i * 64 + lane;
        bgt += __builtin_popcountll(mgt);
      }
      int beq = bgt;
#pragma unroll
      for (int i = 0; i < 64; ++i) {
        const unsigned long long meq = __ballot(u[i] == thr);
        const int pos = beq + __builtin_amdgcn_mbcnt_hi((unsigned)(meq >> 32), __builtin_amdgcn_mbcnt_lo((unsigned)meq, 0u));
        if (u[i] == thr && pos < 256) sidx[pos] = i * 64 + lane;
        beq += __builtin_popcountll(meq);
      }
    }
  }
  __syncthreads();
#pragma unroll 1
  for (int qq = 0; qq < 2; ++qq) {
    const int token = token0 + 2 * w + qq;
    const int* sidx = sidx0 + qq * 256;
#pragma unroll 1
    for (int g = 0; g < 2; ++g) {
      bf16x8 qf0, qf1;
      {
        const bf16_t* qp = qb + (size_t)token * 512 + (g * 4 + (lane & 3)) * 64 + 8 * l4;
        qf0 = *(const bf16x8*)qp; qf1 = *(const bf16x8*)(qp + 32);
      }
      float mx[4] = {-INFINITY, -INFINITY, -INFINITY, -INFINITY};
#pragma unroll
      for (int t = 0; t < 16; ++t) {
        const int key = sidx[t * 16 + l15];
        const bf16_t* kp = kb + (size_t)(b * SEQ + key) * 128 + g * 64 + 8 * l4;
        const bf16x8 k0 = *(const bf16x8*)kp; const bf16x8 k1 = *(const bf16x8*)(kp + 32);
        f32x4 ac = {0.f, 0.f, 0.f, 0.f};
        ac = MFMA16(qf0, k0, ac);
        ac = MFMA16(qf1, k1, ac);
        const bool ok = (t * 16 + l15) < cntsel;
        f32x4 lgv;
#pragma unroll
        for (int i = 0; i < 4; ++i) { lgv[i] = ok ? ac[i] * 0.125f : -INFINITY; mx[i] = fmaxf(mx[i], lgv[i]); }
        if (l4 == (t & 3)) *(f32x4*)(spl + (t * 16 + l15) * 4) = lgv;
        if ((t & 3) == 3) __builtin_amdgcn_sched_barrier(0);
      }
#pragma unroll
      for (int i = 0; i < 4; ++i) {
#pragma unroll
        for (int o = 1; o < 16; o <<= 1) mx[i] = fmaxf(mx[i], __shfl_xor(mx[i], o));
      }
      __syncthreads();
      float sm[4] = {0.f, 0.f, 0.f, 0.f};
#pragma unroll
      for (int jj = 0; jj < 4; ++jj) {
        f32x4 pv = *(const f32x4*)(spl + (jj * 64 + lane) * 4);
#pragma unroll
        for (int i = 0; i < 4; ++i) { pv[i] = __expf(pv[i] - mx[i]); sm[i] += pv[i]; }
        *(f32x4*)(spl + (jj * 64 + lane) * 4) = pv;
      }
#pragma unroll
      for (int i = 0; i < 4; ++i) {
#pragma unroll
        for (int o = 1; o < 64; o <<= 1) sm[i] += __shfl_xor(sm[i], o);
      }
      __syncthreads();
      const int dp = lane & 31, hh2 = lane >> 5;
      float ao[4][2];
#pragma unroll
      for (int i = 0; i < 4; ++i) { ao[i][0] = 0.f; ao[i][1] = 0.f; }
      const bf16_t* vbase = vb + (size_t)b * SEQ * 128 + g * 64 + 2 * dp;
#pragma unroll 8
      for (int kk = 0; kk < 128; ++kk) {
        const int slot = 2 * kk + hh2;
        const int key = sidx[slot];
        const f32x4 pv = *(const f32x4*)(spl + slot * 4);
        const unsigned v2 = *(const unsigned*)(vbase + (size_t)key * 128);
        const float vlo = __uint_as_float(v2 << 16), vhi = __uint_as_float(v2 & 0xffff0000u);
#pragma unroll
        for (int i = 0; i < 4; ++i) { ao[i][0] += pv[i] * vlo; ao[i][1] += pv[i] * vhi; }
      }
#pragma unroll
      for (int i = 0; i < 4; ++i) {
        ao[i][0] += __shfl_xor(ao[i][0], 32); ao[i][1] += __shfl_xor(ao[i][1], 32);
        const float inv = 1.0f / sm[i];
        if (hh2 == 0) *(unsigned*)(Y + (size_t)token * 1024 + 512 + (g * 4 + i) * 64 + 2 * dp) = pack2(ao[i][0] * inv, ao[i][1] * inv);
      }
      __syncthreads();
    }
  }
}

DI void phase_mixers(const Params& p, char* smem) {
  constexpr int NA = 2048, NB = 4096;
  for (int it = blockIdx.x; it < NA + NB; it += gridDim.x) {
    if (it < NA) mixA_item(p, it, smem);
    else mixB_item(p, it - NA, smem);
    __syncthreads();
  }
}

DI void phase_merge(const Params& p, int layer, char* smem) {
  const bf16_t* Y = (const bf16_t*)(p.ws + OFF_Y);
  const bf16_t* Wa = (const bf16_t*)(p.ws + (size_t)layer * WT_LAYER + WT_UPA);
  const bf16_t* Wb = (const bf16_t*)(p.ws + (size_t)layer * WT_LAYER + WT_UPB);
  const bf16_t* gates = (const bf16_t*)(p.ws + OFF_GATES);
  bf16_t* mg = (bf16_t*)(p.ws + OFF_HBUF);
  const int tid_ = otid(); const int lane = tid_ & 63, wave = tid_ >> 6;
  const int wm = wave >> 1, wn = wave & 1, r = lane & 31, h = lane >> 5;
  constexpr int MT = T_TOK / 128, NT = 8;
  for (int idx = blockIdx.x; idx < MT * NT; idx += gridDim.x) {
    int mi, ni; tile_coord(idx, NT, mi, ni);
    f32x16 acc[2][2];
    zero_acc(acc);
    gemm_tile(Y + 512, 1024, Wb, 512, 512, mi * 128, ni * 128, acc, smem);
#pragma unroll
    for (int i = 0; i < 2; ++i)
#pragma unroll
      for (int j = 0; j < 2; ++j)
#pragma unroll
        for (int g = 0; g < 4; ++g) {
          const int row = mi * 128 + wm * 64 + i * 32 + 8 * g + 4 * h, col = ni * 128 + wn * 64 + j * 32 + r;
          const u32x2 ga2 = *(const u32x2*)(gates + ((size_t)(row >> 2) * 2048 + col) * 4);
          const u32x2 gb2 = *(const u32x2*)(gates + ((size_t)(row >> 2) * 2048 + 1024 + col) * 4);
#pragma unroll
          for (int rr = 0; rr < 4; ++rr) {
            const unsigned wa = ga2[rr >> 1], wb = gb2[rr >> 1];
            const float ga = fmaxf((rr & 1) ? __uint_as_float(wa & 0xffff0000u) : __uint_as_float(wa << 16), 1e-20f);
            const float gb = (rr & 1) ? __uint_as_float(wb & 0xffff0000u) : __uint_as_float(wb << 16);
            acc[i][j][4 * g + rr] *= gb / ga;
          }
        }
    gemm_tile(Y, 1024, Wa, 512, 512, mi * 128, ni * 128, acc, smem);
#pragma unroll
    for (int i = 0; i < 2; ++i)
#pragma unroll
      for (int j = 0; j < 2; ++j)
#pragma unroll
        for (int g = 0; g < 4; ++g) {
          const int row = mi * 128 + wm * 64 + i * 32 + 8 * g + 4 * h, col = ni * 128 + wn * 64 + j * 32 + r;
          const u32x2 ga2 = *(const u32x2*)(gates + ((size_t)(row >> 2) * 2048 + col) * 4);
#pragma unroll
          for (int rr = 0; rr < 4; ++rr) {
            const unsigned wa = ga2[rr >> 1];
            const float ga = fmaxf((rr & 1) ? __uint_as_float(wa & 0xffff0000u) : __uint_as_float(wa << 16), 1e-20f);
            mg[(size_t)(row + rr) * 1024 + col] = f2bf(acc[i][j][4 * g + rr] * ga);
          }
        }
  }
}

DI void phase_gemm_resid(const bf16_t* A, int lda, const bf16_t* Bt, int K, const float* resid, float* out, char* smem) {
  const int tid_ = otid(); const int lane = tid_ & 63, wave = tid_ >> 6;
  const int wm = wave >> 1, wn = wave & 1, r = lane & 31, h = lane >> 5;
  constexpr int MT = T_TOK / 128, NT = 8;
  for (int idx = blockIdx.x; idx < MT * NT; idx += gridDim.x) {
    int mi, ni; tile_coord(idx, NT, mi, ni);
    f32x16 acc[2][2]; zero_acc(acc);
    gemm_tile(A, lda, Bt, K, K, mi * 128, ni * 128, acc, smem);
#pragma unroll
    for (int i = 0; i < 2; ++i)
#pragma unroll
      for (int j = 0; j < 2; ++j)
#pragma unroll
        for (int e = 0; e < 16; ++e) {
          const size_t off = (size_t)(mi * 128 + wm * 64 + i * 32 + crow(e, h)) * 1024 + ni * 128 + wn * 64 + j * 32 + r;
          out[off] = resid[off] + acc[i][j][e];
        }
  }
}

DI void phase_ff1(const Params& p, int layer, char* smem) {
  const bf16_t* A = (const bf16_t*)(p.ws + OFF_HBUF);
  const bf16_t* Bt = (const bf16_t*)(p.ws + (size_t)layer * WT_LAYER + WT_FF1);
  bf16_t* hid = (bf16_t*)(p.ws + OFF_HIDDEN);
  const int tid_ = otid(); const int lane = tid_ & 63, wave = tid_ >> 6;
  const int wm = wave >> 1, wn = wave & 1, r = lane & 31, h = lane >> 5;
  constexpr int MT = T_TOK / 128, NT = 32;
  for (int idx = blockIdx.x; idx < MT * NT; idx += gridDim.x) {
    int mi, ni; tile_coord(idx, NT, mi, ni);
    f32x16 acc[2][2]; zero_acc(acc);
    gemm_tile(A, 1024, Bt, 1024, 1024, mi * 128, ni * 128, acc, smem);
#pragma unroll
    for (int i = 0; i < 2; ++i)
#pragma unroll
      for (int j = 0; j < 2; ++j)
#pragma unroll
        for (int e = 0; e < 16; ++e) {
          const float v = fmaxf(acc[i][j][e], 0.f);
          hid[(size_t)(mi * 128 + wm * 64 + i * 32 + crow(e, h)) * 4096 + ni * 128 + wn * 64 + j * 32 + r] = f2bf(v * v);
        }
  }
}

__global__ void __launch_bounds__(256, 2) fwd_megakernel(Params p) {
  cg::grid_group grid = cg::this_grid();
  __shared__ __attribute__((aligned(16))) char smem[2 * 128 * SROW];
  phase_prep(p, smem);
  grid.sync();
#pragma unroll 1
  for (int layer = 0; layer < 2; ++layer) {
    const float* xin = layer == 0 ? p.x : p.out;
    phase_rmsnorm<false>(xin, p.g_mix + layer * DM, (bf16_t*)(p.ws + OFF_HBUF), nullptr);
    grid.sync();
    phase_inproj(p, layer, smem);
    grid.sync();
    phase_mixers(p, smem);
    grid.sync();
    phase_merge(p, layer, smem);
    grid.sync();
    phase_gemm_resid((const bf16_t*)(p.ws + OFF_HBUF), 1024, (const bf16_t*)(p.ws + (size_t)layer * WT_LAYER + WT_O), 1024, xin, p.out, smem);
    grid.sync();
    phase_rmsnorm<false>(p.out, p.g_mlp + layer * DM, (bf16_t*)(p.ws + OFF_HBUF), nullptr);
    grid.sync();
    phase_ff1(p, layer, smem);
    grid.sync();
    phase_gemm_resid((const bf16_t*)(p.ws + OFF_HIDDEN), 4096, (const bf16_t*)(p.ws + (size_t)layer * WT_LAYER + WT_FF2), 4096, p.out, p.out, smem);
    grid.sync();
  }
  phase_rmsnorm<true>(p.out, p.g_final, nullptr, p.out);
}

extern "C" void kernel_launch(void* const* d_in, const int* in_sizes, int n_in,
                              void* d_out, int out_size, void* d_ws, size_t ws_size,
                              hipStream_t stream) {
  static int grid_blocks = 0;
  if (!grid_blocks) {
    int dev = 0, cus = 0, per_cu = 0;
    (void)hipGetDevice(&dev);
    (void)hipDeviceGetAttribute(&cus, hipDeviceAttributeMultiprocessorCount, dev);
    (void)hipOccupancyMaxActiveBlocksPerMultiprocessor(&per_cu, fwd_megakernel, 256, 0);
    if (per_cu > 2) per_cu = 2;
    if (per_cu < 1) per_cu = 1;
    grid_blocks = cus * per_cu;
  }
  Params p{};
  p.x = (const float*)d_in[0]; p.g_mix = (const float*)d_in[1]; p.w_in = (const float*)d_in[2];
  p.w_up_a = (const float*)d_in[3]; p.w_up_b = (const float*)d_in[4]; p.w_o = (const float*)d_in[5];
  p.g_mlp = (const float*)d_in[6]; p.w_ff1 = (const float*)d_in[7]; p.w_ff2 = (const float*)d_in[8];
  p.g_final = (const float*)d_in[9];
  p.out = (float*)d_out; p.ws = (char*)d_ws;
  void* args[] = {&p};
  hipError_t e = hipLaunchCooperativeKernel((void*)fwd_megakernel, dim3(grid_blocks), dim3(256), args, 0, stream);
  if (e != hipSuccess) fprintf(stderr, "cooperative launch failed: %s (grid %d)\n", hipGetErrorString(e), grid_blocks);
}
```

```cpp
#include <hip/hip_runtime.h>
#include <hip/hip_bf16.h>
#include <hip/hip_cooperative_groups.h>
#include <cstdio>
namespace cg = cooperative_groups;

#define DI __device__ __forceinline__
typedef __bf16 bf2_t __attribute__((ext_vector_type(2)));
typedef float fl2_t __attribute__((ext_vector_type(2)));
DI int otid() { int t = threadIdx.x; asm volatile("" : "+v"(t)); return t; }

#define XB_TMO      128
#define XB_XCNT(j)  (256  + 64 * (j))
#define XB_XSUB(j)  (1280 + 64 * (j))
#define XB_XGEN(j)  (2304 + 64 * (j))
#define XB_TOP      3328
#define XB_TOPGEN   3392
#define XCD_BAR_WORDS 3456
#define XB_SPIN_CAP (1u << 18)
#define LAS __attribute__((address_space(3)))

__device__ __forceinline__ unsigned xb_ld(unsigned* p)              { return __hip_atomic_load(p, __ATOMIC_RELAXED, __HIP_MEMORY_SCOPE_AGENT); }
__device__ __forceinline__ unsigned xb_add(unsigned* p, unsigned v) { return __hip_atomic_fetch_add(p, v, __ATOMIC_RELAXED, __HIP_MEMORY_SCOPE_AGENT); }
__device__ __forceinline__ unsigned xb_xcc_id() { return (unsigned)__builtin_amdgcn_s_getreg((3 << 11) | 20) & 0xFu; }
#define XB_SPIN(cond, bar) do { unsigned _sp = 0; while (cond) { __builtin_amdgcn_s_sleep(1); \
    if ((++_sp & 255u) == 0u) { if (xb_ld(&(bar)[XB_TMO])) break; if (_sp > XB_SPIN_CAP) { atomicAdd(&(bar)[XB_TMO], 1u); break; } } } } while (0)

struct XcdBarrier {
    unsigned* bar; unsigned x;
    volatile LAS unsigned* st;
};

__device__ __forceinline__ XcdBarrier xcd_barrier_post(unsigned* bar, volatile LAS unsigned* st) {
    XcdBarrier b; b.bar = bar; b.x = xb_xcc_id(); b.st = st;
    if (otid() == 0) (void)xb_add(&bar[XB_XCNT(b.x)], 1u);
    return b;
}
__device__ __forceinline__ void xcd_barrier_complete(unsigned* bar, unsigned x, unsigned& nloc, unsigned& nx) {
    const unsigned G = gridDim.x * gridDim.y * gridDim.z;
    unsigned sum, cnt, mine, sp = 0u;
    for (;;) {
        sum = 0u; cnt = 0u; mine = 0u;
#pragma unroll
        for (unsigned j = 0; j < 16; ++j) { const unsigned c = xb_ld(&bar[XB_XCNT(j)]); sum += c; cnt += (c > 0u) ? 1u : 0u; mine = (j == x) ? c : mine; }
        if (sum == G) break;
        __builtin_amdgcn_s_sleep(1);
        if ((++sp & 255u) == 0u) { if (xb_ld(&bar[XB_TMO])) break; if (sp > XB_SPIN_CAP) { atomicAdd(&bar[XB_TMO], 1u); break; } }
    }
    nloc = mine > 0u ? mine : 1u; nx = cnt > 0u ? cnt : 1u;
}

__device__ __forceinline__ void xcd_barrier(const XcdBarrier& b) {
    asm volatile("s_waitcnt vmcnt(0)" ::: "memory");
    __syncthreads();
    if (otid() == 0) {
        unsigned* bar = b.bar; unsigned bx_ = b.x;
        asm volatile("" : "+s"(bar), "+s"(bx_));
        __builtin_amdgcn_s_waitcnt(0);
        unsigned nloc = b.st[0], nx = b.st[1];
        if (nloc == 0u) { xcd_barrier_complete(bar, bx_, nloc, nx); b.st[0] = nloc; b.st[1] = nx; }
        const unsigned old = xb_add(&bar[XB_XSUB(bx_)], 1u);
        const unsigned gen = old / nloc;
        if (old + 1u == (gen + 1u) * nloc) {
            __builtin_amdgcn_fence(__ATOMIC_RELEASE, "agent");
            asm volatile("s_waitcnt vmcnt(0)" ::: "memory");
            const unsigned og = xb_add(&bar[XB_TOP], 1u);
            const unsigned tg = og / nx;
            if (og + 1u == (tg + 1u) * nx) xb_add(&bar[XB_TOPGEN], 1u);
            else XB_SPIN(xb_ld(&bar[XB_TOPGEN]) == tg, bar);
            __builtin_amdgcn_fence(__ATOMIC_ACQUIRE, "agent");
            xb_add(&bar[XB_XGEN(bx_)], 1u);
            asm volatile("s_waitcnt vmcnt(0)" ::: "memory");
        } else {
            XB_SPIN(xb_ld(&bar[XB_XGEN(bx_)]) == gen, bar);
            __builtin_amdgcn_fence(__ATOMIC_ACQUIRE, "agent");
            asm volatile("s_waitcnt vmcnt(0)" ::: "memory");
        }
    }
    __syncthreads();
}

namespace pg8 {
#define PG8_LAS __attribute__((address_space(3)))
typedef unsigned short bf16_t;
typedef short bf16x8 __attribute__((ext_vector_type(8)));
typedef float f32x4 __attribute__((ext_vector_type(4)));
typedef unsigned u32x4 __attribute__((ext_vector_type(4)));
constexpr int BM = 256, BK = 64, HALF = 128, HTB = HALF * BK * 2  , STAGE_BYTES = 8 * HTB, NXCD = 8, WGM = 8;

__host__ __device__ __forceinline__ int lds_byte(int r, int c) { const int st = (r >> 4) * 2 + (c >> 5), rr = r & 15, cc = c & 31, ob = rr * 64 + cc * 2; return st * 1024 + (ob ^ (((ob >> 9) & 1) << 5)); }
__host__ __device__ __forceinline__ void stage_rc(int b, int& R, int& C) { const int st = b / 1024, sb = b % 1024, swz = sb ^ (((sb >> 9) & 1) << 5); R = (st >> 1) * 16 + swz / 64; C = (st & 1) * 32 + (swz % 64) / 2; }
__host__ __device__ __forceinline__ int perm32(int rho) { const int n = rho >> 4, i = rho & 15; return 8 * (i >> 2) + 4 * n + (i & 3); }

struct Unit { int pm, pn; };
struct Gemm { const bf16_t* A; const bf16_t* Bt; int M, N, K; };
struct StaticOrder {
    int nM, nN, nwg, G, c;
    __host__ __device__ void init(int M, int N, int G_, int c_) { nM = M / BM; nN = N / BM; nwg = nM * nN; G = G_; c = c_; }
    __host__ __device__ bool next(int i, Unit& u) const {
        const long L = (long)i * G + c; if (L >= nwg) return false;
        int wgid = (int)L; { const int q = nwg / NXCD, r = nwg % NXCD, xcd = wgid % NXCD, off = wgid / NXCD; wgid = (xcd < r ? xcd * (q + 1) : r * (q + 1) + (xcd - r) * q) + off; }
        const int nig = WGM * nN, gid = wgid / nig, fm = gid * WGM, gsz = (nM - fm) < WGM ? (nM - fm) : WGM;
        u.pm = fm + ((wgid % nig) % gsz); u.pn = (wgid % nig) / gsz; return true;
    }
    __device__ __forceinline__ void a_ready(const Unit&) const {}
    __device__ __forceinline__ void done(const Unit&) const {}
};
template <class Epi, class Sched, bool STAMP = false>
__device__ __forceinline__ void gemm_phase(PG8_LAS unsigned char* lds, const Gemm g, const Sched& S, const Epi& E, unsigned long long* stamps) {
    const int tid = otid(), wid = __builtin_amdgcn_readfirstlane(tid >> 6), lane = tid & 63, wr = wid >> 2, wc = wid & 3, fr = lane & 15, fq = lane >> 4;
    const int K = g.K, nt = K / BK;
    int ts_lo = 0, ts_hi = 0, nts = 0; const unsigned long long rt_entry = STAMP ? (unsigned long long)wall_clock64() : 0ull;
#define PG8_STAMP() do { if (STAMP && wid == 0 && nts < 64) { const unsigned long long _c = (unsigned long long)clock64(); \
        ts_lo = (lane == nts) ? (int)(unsigned)_c : ts_lo; ts_hi = (lane == nts) ? (int)(unsigned)(_c >> 32) : ts_hi; ++nts; } } while (0)
    PG8_STAMP();
    unsigned voffA[2], voffB[2];
#pragma unroll
    for (int i = 0; i < 2; ++i) { int R, C; stage_rc(tid * 16 + i * 8192, R, C); const int Rb = Epi::PERM ? ((R & ~31) + perm32(R & 31)) : R;
        voffA[i] = (unsigned)(R * K + C) * 2u; voffB[i] = (unsigned)(Rb * K + C) * 2u; }
    const size_t kstep = (size_t)(BK * 2);
    const size_t hstep = (size_t)HALF * K * 2;
    const size_t tstep = 2 * hstep;
    const unsigned ldsw = (unsigned)wid * 1024u;
    const int aoff = lds_byte(wr * 64 + fr, fq * 8), boff = lds_byte(wc * 32 + fr, fq * 8);
#define PG8_SA(b, h) (((b) * 2 + (h)) * HTB)
#define PG8_SB(b, h) ((4 + (b) * 2 + (h)) * HTB)
#define PG8_STAGE(bufoff, gbase, voff) do { _Pragma("unroll") for (int _i = 0; _i < 2; ++_i) \
        __builtin_amdgcn_global_load_lds((const unsigned*)((const char*)(gbase) + (voff)[_i]), (PG8_LAS unsigned*)(lds + (bufoff) + ldsw + _i * 8192), 16, 0, 0); } while (0)
#define PG8_LDA(dst, b, h) do { _Pragma("unroll") for (int m = 0; m < 4; ++m) _Pragma("unroll") for (int k = 0; k < 2; ++k) dst[m][k] = *(const PG8_LAS bf16x8*)(lds + PG8_SA(b, h) + aoff + m * 2048 + k * 1024); } while (0)
#define PG8_LDB(dst, b, h) do { _Pragma("unroll") for (int n = 0; n < 2; ++n) _Pragma("unroll") for (int k = 0; k < 2; ++k) dst[n][k] = *(const PG8_LAS bf16x8*)(lds + PG8_SB(b, h) + boff + n * 2048 + k * 1024); } while (0)
#define PG8_MMA(ai, bj, At, Bt) do { __builtin_amdgcn_s_setprio(1); _Pragma("unroll") for (int m = 0; m < 4; ++m) _Pragma("unroll") for (int n = 0; n < 2; ++n) _Pragma("unroll") for (int k = 0; k < 2; ++k) \
        acc[ai][bj][m][n] = __builtin_amdgcn_mfma_f32_16x16x32_bf16(Bt[n][k], At[m][k], acc[ai][bj][m][n], 0, 0, 0); __builtin_amdgcn_s_setprio(0); } while (0)
#define PG8_WAIT_V(n) asm volatile("s_waitcnt vmcnt(" #n ")" ::: "memory")
#define PG8_WAIT_L(n) asm volatile("s_waitcnt lgkmcnt(" #n ")" ::: "memory")
#define PG8_BAR __builtin_amdgcn_s_barrier()
#define PG8_SCHED __builtin_amdgcn_sched_barrier(0)
    Unit cur, nxt; int ui = 0;
    if (!S.next(0, cur)) return;
    f32x4 acc[2][2][4][2];
#pragma unroll
    for (int a = 0; a < 2; ++a)
#pragma unroll
        for (int b = 0; b < 2; ++b)
#pragma unroll
            for (int m = 0; m < 4; ++m)
#pragma unroll
                for (int n = 0; n < 2; ++n) acc[a][b][m][n] = (f32x4){0.f, 0.f, 0.f, 0.f};
    bf16x8 At[4][2], B0[2][2], B1[2][2];
    const char* cA = (const char*)g.A + (size_t)cur.pm * tstep; const char* cB = (const char*)g.Bt + (size_t)cur.pn * tstep;
    S.a_ready(cur);
    PG8_STAGE(PG8_SB(0, 0), cB, voffB); PG8_STAGE(PG8_SA(0, 0), cA, voffA); PG8_STAGE(PG8_SB(0, 1), cB + hstep, voffB); PG8_STAGE(PG8_SA(0, 1), cA + hstep, voffA);
    if (wr == 1) PG8_BAR;
    PG8_WAIT_V(4); PG8_BAR;
    PG8_STAGE(PG8_SB(1, 0), cB + kstep, voffB); PG8_STAGE(PG8_SA(1, 0), cA + kstep, voffA); PG8_STAGE(PG8_SB(1, 1), cB + hstep + kstep, voffB);
    PG8_WAIT_V(6); PG8_BAR;
    PG8_STAMP();
    for (;;) {
        const bool has_next = S.next(ui + 1, nxt);
        const char* nA = has_next ? (const char*)g.A + (size_t)nxt.pm * tstep : cA; const char* nB = has_next ? (const char*)g.Bt + (size_t)nxt.pn * tstep : cB;
        for (int t = 0; t < nt; t += 2) {
            if constexpr (Epi::MIDK) { if (t == nt / 2) E.mid(acc, cur, wr, wc, fr, fq); }
            const bool last = (t == nt - 2);
            const char* a1 = cA + (size_t)(t + 1) * kstep;
            const char* a2 = last ? nA : cA + (size_t)(t + 2) * kstep; const char* b2 = last ? nB : cB + (size_t)(t + 2) * kstep;
            const char* a3 = a2 + kstep; const char* b3 = b2 + kstep;
            if (last && has_next) S.a_ready(nxt);
            PG8_LDB(B0, 0, 0); PG8_SCHED; PG8_LDA(At, 0, 0); PG8_STAGE(PG8_SA(1, 1), a1 + hstep, voffA);
            PG8_WAIT_L(8); PG8_BAR; PG8_WAIT_L(0); PG8_MMA(0, 0, At, B0); PG8_BAR; PG8_SCHED;
            PG8_LDB(B1, 0, 1); PG8_STAGE(PG8_SB(0, 0), b2, voffB);
            PG8_BAR; PG8_WAIT_L(0); PG8_MMA(0, 1, At, B1); PG8_BAR;
            PG8_LDA(At, 0, 1); PG8_STAGE(PG8_SA(0, 0), a2, voffA);
            PG8_BAR; PG8_WAIT_L(0); PG8_MMA(1, 0, At, B0); PG8_BAR; PG8_SCHED;
            PG8_STAGE(PG8_SB(0, 1), b2 + hstep, voffB);
            PG8_WAIT_V(6); PG8_BAR; PG8_MMA(1, 1, At, B1); PG8_BAR;
            PG8_LDB(B0, 1, 0); PG8_SCHED; PG8_LDA(At, 1, 0); PG8_STAGE(PG8_SA(0, 1), a2 + hstep, voffA);
            PG8_WAIT_L(8); PG8_BAR; PG8_WAIT_L(0); PG8_MMA(0, 0, At, B0); PG8_BAR; PG8_SCHED;
            PG8_LDB(B1, 1, 1); PG8_STAGE(PG8_SB(1, 0), b3, voffB);
            PG8_BAR; PG8_WAIT_L(0); PG8_MMA(0, 1, At, B1); PG8_BAR;
            PG8_LDA(At, 1, 1); PG8_STAGE(PG8_SA(1, 0), a3, voffA);
            PG8_BAR; PG8_WAIT_L(0); PG8_MMA(1, 0, At, B0); PG8_BAR; PG8_SCHED;
            PG8_STAGE(PG8_SB(1, 1), b3 + hstep, voffB);
            PG8_WAIT_V(6); PG8_BAR; PG8_MMA(1, 1, At, B1); PG8_BAR;
        }
        PG8_STAMP();
        if constexpr (!Epi::AFTER_DRAIN) { E(acc, cur, wr, wc, fr, fq); S.done(cur); }
        PG8_STAMP();
        if (!has_next) break;
#pragma unroll
        for (int a = 0; a < 2; ++a)
#pragma unroll
            for (int b = 0; b < 2; ++b)
#pragma unroll
                for (int m = 0; m < 4; ++m)
#pragma unroll
                    for (int n = 0; n < 2; ++n) acc[a][b][m][n] = (f32x4){0.f, 0.f, 0.f, 0.f};
        cur = nxt; cA = nA; cB = nB; ++ui;
    }
    PG8_WAIT_V(0);
    if (wr == 0) PG8_BAR;
    PG8_BAR;
    if constexpr (Epi::AFTER_DRAIN) { E.fused(acc, cur, wr, wc, fr, fq, lds, wid, lane); S.done(cur); }
    PG8_STAMP();
    if (STAMP && wid == 0) { stamps[lane] = lane < nts ? (((unsigned long long)(unsigned)ts_hi << 32) | (unsigned)ts_lo) : 0ull;
        if (lane == 62) stamps[62] = rt_entry; if (lane == 63) stamps[63] = (unsigned long long)wall_clock64(); }
#undef PG8_STAMP
#undef PG8_SA
#undef PG8_SB
#undef PG8_STAGE
#undef PG8_LDA
#undef PG8_LDB
#undef PG8_MMA
#undef PG8_WAIT_V
#undef PG8_WAIT_L
#undef PG8_BAR
#undef PG8_SCHED
}
}

typedef unsigned short bf16_t;
using bf16x8 = __attribute__((ext_vector_type(8))) short;
using s16x4  = __attribute__((ext_vector_type(4))) short;
using f32x16 = __attribute__((ext_vector_type(16))) float;
using f32x4  = __attribute__((ext_vector_type(4))) float;
using u32x4  = __attribute__((ext_vector_type(4))) unsigned;
using u32x2  = __attribute__((ext_vector_type(2))) unsigned;

#define MFMA32(a, b, c) __builtin_amdgcn_mfma_f32_32x32x16_bf16((a), (b), (c), 0, 0, 0)
#define MFMA16(a, b, c) __builtin_amdgcn_mfma_f32_16x16x32_bf16((a), (b), (c), 0, 0, 0)

constexpr int NTHR = 512, NWAVE = 8;
constexpr int T_TOK = 32768, SEQ = 4096, DM = 1024;
constexpr int NPAD_IN = 4864;
constexpr int SROW = 144;
constexpr int WAVE_LDS = 17408;
constexpr int LDS_BYTES = 8 * WAVE_LDS;

constexpr size_t WT_IN = 0;
constexpr size_t WT_UPA = WT_IN + (size_t)NPAD_IN * 1024 * 2;
constexpr size_t WT_UPB = WT_UPA + (size_t)1024 * 512 * 2;
constexpr size_t WT_O   = WT_UPB + (size_t)1024 * 512 * 2;
constexpr size_t WT_FF1 = WT_O + (size_t)1024 * 1024 * 2;
constexpr size_t WT_FF2 = WT_FF1 + (size_t)4096 * 1024 * 2;
constexpr size_t WT_LAYER = WT_FF2 + (size_t)1024 * 4096 * 2;
constexpr size_t OFF_ROPE = 2 * WT_LAYER;
constexpr size_t OFF_QA = OFF_ROPE + (size_t)SEQ * 24 * 4;
constexpr size_t OFF_KA = OFF_QA + (size_t)T_TOK * 512 * 2;
constexpr size_t OFF_VAT = OFF_KA + (size_t)T_TOK * 512 * 2;
constexpr size_t OFF_QB = OFF_VAT + (size_t)T_TOK * 512 * 2;
constexpr size_t OFF_KB = OFF_QB + (size_t)T_TOK * 512 * 2;
constexpr size_t OFF_VB = OFF_KB + (size_t)T_TOK * 128 * 2;
constexpr size_t OFF_QI = OFF_VB + (size_t)T_TOK * 128 * 2;
constexpr size_t OFF_KI = OFF_QI + (size_t)T_TOK * 256 * 2;
constexpr size_t OFF_WI = OFF_KI + (size_t)T_TOK * 32 * 2;
constexpr size_t OFF_GATES = OFF_WI + (size_t)T_TOK * 8 * 4;
constexpr size_t OFF_PROJ_END = OFF_GATES + (size_t)T_TOK * 2048 * 2;
constexpr size_t OFF_HIDDEN = OFF_QA;
constexpr size_t OFF_YA = OFF_PROJ_END;
constexpr size_t OFF_YB = OFF_YA + (size_t)T_TOK * 512 * 2;
constexpr size_t OFF_HBUF = OFF_YB + (size_t)T_TOK * 512 * 2;
constexpr size_t OFF_END = OFF_HBUF + (size_t)T_TOK * 1024 * 2;
constexpr size_t OFF_BAR = OFF_END;
static_assert(OFF_BAR + XCD_BAR_WORDS * 4 <= (size_t)512 * 1024 * 1024, "workspace too large");
static_assert(OFF_HIDDEN + (size_t)T_TOK * 4096 * 2 <= OFF_PROJ_END, "hidden alias");

struct Params {
  const float* x; const float* g_mix; const float* w_in; const float* w_up_a; const float* w_up_b;
  const float* w_o; const float* g_mlp; const float* w_ff1; const float* w_ff2; const float* g_final;
  float* out; char* ws;
};

DI unsigned pack2(float a, float b) {
  fl2_t f = {a, b};
  bf2_t r = __builtin_convertvector(f, bf2_t);
  return __builtin_bit_cast(unsigned, r);
}
DI bf16_t f2bf(float a) { return (bf16_t)(pack2(a, 0.f) & 0xffffu); }
DI float bflo(unsigned w) { return __uint_as_float(w << 16); }
DI float bfhi(unsigned w) { return __uint_as_float(w & 0xffff0000u); }
DI int crow(int reg, int h) { return (reg & 3) + 8 * (reg >> 2) + 4 * h; }
DI u32x4 pack8(const f32x4& a, const f32x4& b) {
  u32x4 w; w[0] = pack2(a[0], a[1]); w[1] = pack2(a[2], a[3]); w[2] = pack2(b[0], b[1]); w[3] = pack2(b[2], b[3]); return w;
}

DI int src_col(int nd, int mode) {
  if (!mode) return nd;
  if (nd < 2560) return nd;
  if (nd < 4608) { const int blk = (nd - 2560) >> 7; return 2600 + (blk & 1) * 1024 + (blk >> 1) * 128 + (nd & 127); }
  if (nd < 4648) return nd - 2048;
  return -1;
}
DI void convT(const float* __restrict__ W, int K, int N, bf16_t* __restrict__ WT, int NR, int mode, char* smem, int ldw = 0, int koff = 0) {
  if (ldw == 0) ldw = K;
  float* tile = (float*)smem;
  const int tid = otid();
  const int kt_n = K / 64, nt_n = NR / 64;
  for (int t = blockIdx.x; t < kt_n * nt_n; t += gridDim.x) {
    const int k0 = (t % kt_n) * 64, n0 = (t / kt_n) * 64;
    const int nl = tid & 63;
    const int sc = src_col(n0 + nl, mode);
    __syncthreads();
#pragma unroll
    for (int r = 0; r < 8; ++r) {
      const int kl = r * 8 + (tid >> 6);
      float v = 0.f;
      if (sc >= 0) v = W[(size_t)(k0 + kl) * N + sc];
      tile[kl * 65 + nl] = v;
    }
    __syncthreads();
    const int nrow = tid >> 3, ks = (tid & 7) * 8;
    u32x4 o0;
#pragma unroll
    for (int j = 0; j < 4; ++j) o0[j] = pack2(tile[(ks + 2 * j) * 65 + nrow], tile[(ks + 2 * j + 1) * 65 + nrow]);
    *(u32x4*)(WT + (size_t)(n0 + nrow) * ldw + koff + k0 + ks) = o0;
  }
}

DI void phase_prep(const Params& p, char* smem) {
  for (int l = 0; l < 2; ++l) {
    char* wl = p.ws + (size_t)l * WT_LAYER;
    convT(p.w_in + (size_t)l * 1024 * 4648, 1024, 4648, (bf16_t*)(wl + WT_IN), NPAD_IN, 1, smem);
    convT(p.w_up_b + (size_t)l * 512 * 1024, 512, 1024, (bf16_t*)(wl + WT_UPA), 1024, 0, smem, 1024, 0);
    convT(p.w_up_a + (size_t)l * 512 * 1024, 512, 1024, (bf16_t*)(wl + WT_UPA), 1024, 0, smem, 1024, 512);
    convT(p.w_o + (size_t)l * 1024 * 1024, 1024, 1024, (bf16_t*)(wl + WT_O), 1024, 0, smem);
    convT(p.w_ff1 + (size_t)l * 1024 * 4096, 1024, 4096, (bf16_t*)(wl + WT_FF1), 4096, 0, smem);
    convT(p.w_ff2 + (size_t)l * 4096 * 1024, 4096, 1024, (bf16_t*)(wl + WT_FF2), 1024, 0, smem);
  }
  float* rope = (float*)(p.ws + OFF_ROPE);
  for (int i = blockIdx.x * NTHR + otid(); i < SEQ * 12; i += gridDim.x * NTHR) {
    const int pos = i / 12, f = i % 12;
    float inv; int co, so;
    if (f < 8) { inv = powf(500000.0f, -((float)(2 * f) / 16.0f)); co = f; so = 8 + f; }
    else { inv = powf(500000.0f, -((float)(2 * (f - 8)) / 8.0f)); co = 16 + (f - 8); so = 20 + (f - 8); }
    const float ang = (float)pos * inv;
    float s, c; sincosf(ang, &s, &c);
    rope[pos * 24 + co] = c; rope[pos * 24 + so] = s;
  }
}

template <bool IN_BF, bool FINAL>
DI void phase_rmsnorm(const void* __restrict__ xin_, const float* __restrict__ g, bf16_t* __restrict__ hout, float* __restrict__ fout) {
  const int tid_ = otid(); const int wave = tid_ >> 6, lane = tid_ & 63;
  for (int t = blockIdx.x * NWAVE + wave; t < T_TOK; t += gridDim.x * NWAVE) {
    float v[16]; float ss = 0.f;
    if (IN_BF) {
      const u32x4* src = (const u32x4*)((const bf16_t*)xin_ + (size_t)t * DM);
#pragma unroll
      for (int i = 0; i < 2; ++i) {
        const u32x4 w4 = src[lane + 64 * i];
#pragma unroll
        for (int j = 0; j < 4; ++j) { v[8 * i + 2 * j] = bflo(w4[j]); v[8 * i + 2 * j + 1] = bfhi(w4[j]); }
      }
    } else {
      const float4* src = (const float4*)((const float*)xin_ + (size_t)t * DM);
#pragma unroll
      for (int i = 0; i < 4; ++i) { const float4 f = src[2 * lane + 128 * (i >> 1) + (i & 1)]; v[4 * i] = f.x; v[4 * i + 1] = f.y; v[4 * i + 2] = f.z; v[4 * i + 3] = f.w; }
    }
#pragma unroll
    for (int k = 0; k < 16; ++k) ss += v[k] * v[k];
#pragma unroll
    for (int o = 32; o > 0; o >>= 1) ss += __shfl_xor(ss, o);
    const float r = rsqrtf(ss * (1.0f / DM) + 1e-6f);
#pragma unroll
    for (int i = 0; i < 2; ++i) {
      const int e0 = (lane + 64 * i) * 8;
      const float4 g0 = *(const float4*)(g + e0), g1 = *(const float4*)(g + e0 + 4);
      float o8[8];
      o8[0] = v[8 * i] * r * g0.x; o8[1] = v[8 * i + 1] * r * g0.y; o8[2] = v[8 * i + 2] * r * g0.z; o8[3] = v[8 * i + 3] * r * g0.w;
      o8[4] = v[8 * i + 4] * r * g1.x; o8[5] = v[8 * i + 5] * r * g1.y; o8[6] = v[8 * i + 6] * r * g1.z; o8[7] = v[8 * i + 7] * r * g1.w;
      if (FINAL) {
        float4 a, b; a.x = o8[0]; a.y = o8[1]; a.z = o8[2]; a.w = o8[3]; b.x = o8[4]; b.y = o8[5]; b.z = o8[6]; b.w = o8[7];
        *(float4*)(fout + (size_t)t * DM + e0) = a; *(float4*)(fout + (size_t)t * DM + e0 + 4) = b;
      } else {
        u32x4 w4; w4[0] = pack2(o8[0], o8[1]); w4[1] = pack2(o8[2], o8[3]); w4[2] = pack2(o8[4], o8[5]); w4[3] = pack2(o8[6], o8[7]);
        *(u32x4*)(hout + (size_t)t * DM + e0) = w4;
      }
    }
  }
}


struct EpiInproj {
  static constexpr bool PERM = true, AFTER_DRAIN = false, MIDK = false;
  char* ws;
  DI void operator()(const f32x4 (&acc)[2][2][4][2], const pg8::Unit& u, int wr, int wc, int fr_in, int fq_in) const {
    int fr = fr_in, fq = fq_in; asm volatile("" : "+v"(fr), "+v"(fq));
    const float* rope = (const float*)(ws + OFF_ROPE);
    bf16_t* qa = (bf16_t*)(ws + OFF_QA); bf16_t* ka = (bf16_t*)(ws + OFF_KA); bf16_t* vaT = (bf16_t*)(ws + OFF_VAT);
    bf16_t* qb = (bf16_t*)(ws + OFF_QB); bf16_t* kb = (bf16_t*)(ws + OFF_KB); bf16_t* vb = (bf16_t*)(ws + OFF_VB);
    bf16_t* qi = (bf16_t*)(ws + OFF_QI); bf16_t* ki = (bf16_t*)(ws + OFF_KI); float* wi = (float*)(ws + OFF_WI);
    bf16_t* gates = (bf16_t*)(ws + OFF_GATES);
    const int cl8 = wc * 32 + 8 * fq;
    if (u.pn >= 10 && u.pn < 18) {
      bf16_t* gA = (bf16_t*)(ws + OFF_GATES); bf16_t* gR = gA + (size_t)T_TOK * 1024;
      const int ch0 = (u.pn - 10) * 128 + cl8;
#pragma unroll
      for (int ai = 0; ai < 2; ++ai)
#pragma unroll
        for (int m = 0; m < 4; ++m) {
          const int tok = u.pm * 256 + ai * 128 + wr * 64 + m * 16 + fr;
          f32x4 a0 = acc[ai][0][m][0], a1 = acc[ai][0][m][1], b0 = acc[ai][1][m][0], b1 = acc[ai][1][m][1];
#pragma unroll
          for (int j = 0; j < 4; ++j) {
            a0[j] = __builtin_amdgcn_rcpf(1.0f + __expf(-a0[j])); a1[j] = __builtin_amdgcn_rcpf(1.0f + __expf(-a1[j]));
            b0[j] = __builtin_amdgcn_rcpf(1.0f + __expf(-b0[j])); b1[j] = __builtin_amdgcn_rcpf(1.0f + __expf(-b1[j]));
          }
          const u32x4 wa4 = pack8(a0, a1);
          *(u32x4*)(gA + (size_t)tok * 1024 + ch0) = wa4;
          f32x4 r0, r1;
          r0[0] = b0[0] * __builtin_amdgcn_rcpf(fmaxf(bflo(wa4[0]), 1e-20f)); r0[1] = b0[1] * __builtin_amdgcn_rcpf(fmaxf(bfhi(wa4[0]), 1e-20f));
          r0[2] = b0[2] * __builtin_amdgcn_rcpf(fmaxf(bflo(wa4[1]), 1e-20f)); r0[3] = b0[3] * __builtin_amdgcn_rcpf(fmaxf(bfhi(wa4[1]), 1e-20f));
          r1[0] = b1[0] * __builtin_amdgcn_rcpf(fmaxf(bflo(wa4[2]), 1e-20f)); r1[1] = b1[1] * __builtin_amdgcn_rcpf(fmaxf(bfhi(wa4[2]), 1e-20f));
          r1[2] = b1[2] * __builtin_amdgcn_rcpf(fmaxf(bflo(wa4[3]), 1e-20f)); r1[3] = b1[3] * __builtin_amdgcn_rcpf(fmaxf(bfhi(wa4[3]), 1e-20f));
          *(u32x4*)(gR + (size_t)tok * 1024 + ch0) = pack8(r0, r1);
        }
      return;
    }
#pragma unroll
    for (int bj = 0; bj < 2; ++bj) {
      const int ni = u.pn * 2 + bj;
      if (ni >= 37) continue;
#pragma unroll
      for (int ai = 0; ai < 2; ++ai)
#pragma unroll
        for (int m = 0; m < 4; ++m) {
          const int tok = u.pm * 256 + ai * 128 + wr * 64 + m * 16 + fr;
          const int pos = tok & 4095;
          f32x4 v0 = acc[ai][bj][m][0], v1 = acc[ai][bj][m][1];
          if (ni < 8) {
            bf16_t* dst = (ni < 4) ? qa : ka;
            *(u32x4*)(dst + (size_t)tok * 512 + (ni & 3) * 128 + cl8) = pack8(v0, v1);
          } else if (ni < 12) {
            const int c = (ni - 8) * 128 + cl8; const int hd = c >> 6, d = c & 63; const int b = tok >> 12;
            bf16_t* dst = vaT + ((size_t)((b * 8 + hd) * 64 + d)) * SEQ + pos;
#pragma unroll
            for (int j = 0; j < 4; ++j) { dst[(size_t)j * SEQ] = f2bf(v0[j]); dst[(size_t)(j + 4) * SEQ] = f2bf(v1[j]); }
          } else if (ni < 17) {
            const int d0 = cl8 & 63;
            f32x4 p0, p1;
#pragma unroll
            for (int j = 0; j < 4; ++j) { p0[j] = __shfl_xor(v0[j], 16); p1[j] = __shfl_xor(v1[j], 16); }
            if (d0 < 16) {
              const f32x4 c0 = *(const f32x4*)(rope + pos * 24), c1 = *(const f32x4*)(rope + pos * 24 + 4);
              const f32x4 s0 = *(const f32x4*)(rope + pos * 24 + 8), s1 = *(const f32x4*)(rope + pos * 24 + 12);
              if (d0 == 0) { v0 = v0 * c0 - p0 * s0; v1 = v1 * c1 - p1 * s1; }
              else         { v0 = v0 * c0 + p0 * s0; v1 = v1 * c1 + p1 * s1; }
            }
            if (ni < 16) *(u32x4*)(qb + (size_t)tok * 512 + (ni - 12) * 128 + cl8) = pack8(v0, v1);
            else         *(u32x4*)(kb + (size_t)tok * 128 + cl8) = pack8(v0, v1);
          } else if (ni == 17) {
            *(u32x4*)(vb + (size_t)tok * 128 + cl8) = pack8(v0, v1);
          } else if (ni < 20 || ni == 36) {
            if ((cl8 & 31) == 0 && (ni < 20 || cl8 == 0)) {
              const f32x4 cs = *(const f32x4*)(rope + pos * 24 + 16), sn = *(const f32x4*)(rope + pos * 24 + 20);
              const f32x4 a = v0 * cs - v1 * sn, b2 = v1 * cs + v0 * sn;
              v0 = a; v1 = b2;
            }
            if (ni < 20) *(u32x4*)(qi + (size_t)tok * 256 + (ni - 18) * 128 + cl8) = pack8(v0, v1);
            else if (cl8 < 32) *(u32x4*)(ki + (size_t)(tok >> 4) * 512 + (cl8 >> 3) * 128 + (tok & 15) * 8) = pack8(v0, v1);
            else if (cl8 == 32) { *(f32x4*)(wi + (size_t)tok * 8) = v0 * 0.0625f; *(f32x4*)(wi + (size_t)tok * 8 + 4) = v1 * 0.0625f; }
          } else {
#pragma unroll
            for (int j = 0; j < 4; ++j) { v0[j] = __builtin_amdgcn_rcpf(1.0f + __expf(-v0[j])); v1[j] = __builtin_amdgcn_rcpf(1.0f + __expf(-v1[j])); }
            *(u32x4*)(gates + (size_t)tok * 2048 + (ni - 20) * 128 + cl8) = pack8(v0, v1);
          }
        }
    }
  }
};

struct EpiSqrelu {
  static constexpr bool PERM = true, AFTER_DRAIN = false, MIDK = false;
  bf16_t* O;
  DI void operator()(const f32x4 (&acc)[2][2][4][2], const pg8::Unit& u, int wr, int wc, int fr_in, int fq_in) const {
    int fr = fr_in, fq = fq_in; asm volatile("" : "+v"(fr), "+v"(fq));
#pragma unroll
    for (int ai = 0; ai < 2; ++ai)
#pragma unroll
      for (int m = 0; m < 4; ++m) {
        bf16_t* rowp = O + (size_t)(u.pm * 256 + ai * 128 + wr * 64 + m * 16 + fr) * 4096 + u.pn * 256 + wc * 32 + 8 * fq;
#pragma unroll
        for (int bj = 0; bj < 2; ++bj) {
          f32x4 v0 = acc[ai][bj][m][0], v1 = acc[ai][bj][m][1];
#pragma unroll
          for (int j = 0; j < 4; ++j) { const float a = fmaxf(v0[j], 0.f), b = fmaxf(v1[j], 0.f); v0[j] = a * a; v1[j] = b * b; }
          *(u32x4*)(rowp + bj * 128) = pack8(v0, v1);
        }
      }
  }
};

template <bool RF32>
struct EpiResid {
  static constexpr bool PERM = true, AFTER_DRAIN = false, MIDK = false;
  const void* R; bf16_t* O;
  DI void operator()(const f32x4 (&acc)[2][2][4][2], const pg8::Unit& u, int wr, int wc, int fr_in, int fq_in) const {
    int fr = fr_in, fq = fq_in; asm volatile("" : "+v"(fr), "+v"(fq));
#pragma unroll
    for (int ai = 0; ai < 2; ++ai)
#pragma unroll
      for (int m = 0; m < 4; ++m) {
        const size_t ro = (size_t)(u.pm * 256 + ai * 128 + wr * 64 + m * 16 + fr) * 1024 + u.pn * 256 + wc * 32 + 8 * fq;
#pragma unroll
        for (int bj = 0; bj < 2; ++bj) {
          const size_t o = ro + bj * 128;
          f32x4 v0 = acc[ai][bj][m][0], v1 = acc[ai][bj][m][1];
          if (RF32) { v0 += *(const f32x4*)((const float*)R + o); v1 += *(const f32x4*)((const float*)R + o + 4); }
          else {
            const u32x4 rw = *(const u32x4*)((const bf16_t*)R + o);
            v0[0] += bflo(rw[0]); v0[1] += bfhi(rw[0]); v0[2] += bflo(rw[1]); v0[3] += bfhi(rw[1]);
            v1[0] += bflo(rw[2]); v1[1] += bfhi(rw[2]); v1[2] += bflo(rw[3]); v1[3] += bfhi(rw[3]);
          }
          *(u32x4*)(O + o) = pack8(v0, v1);
        }
      }
  }
};

template <int PASS>
struct EpiMerge {
  static constexpr bool PERM = true, AFTER_DRAIN = false, MIDK = false;
  const bf16_t* gates; bf16_t* O;
  DI void operator()(const f32x4 (&acc)[2][2][4][2], const pg8::Unit& u, int wr, int wc, int fr_in, int fq_in) const {
    int fr = fr_in, fq = fq_in; asm volatile("" : "+v"(fr), "+v"(fq));
#pragma unroll
    for (int ai = 0; ai < 2; ++ai)
#pragma unroll
      for (int m = 0; m < 4; ++m) {
        const int tok = u.pm * 256 + ai * 128 + wr * 64 + m * 16 + fr;
        const int c0 = u.pn * 256 + wc * 32 + 8 * fq;
#pragma unroll
        for (int bj = 0; bj < 2; ++bj) {
          const u32x4 gw = *(const u32x4*)(gates + (size_t)tok * 2048 + (PASS == 1 ? 1024 : 0) + c0 + bj * 128);
          f32x4 v0 = acc[ai][bj][m][0], v1 = acc[ai][bj][m][1];
          v0[0] *= bflo(gw[0]); v0[1] *= bfhi(gw[0]); v0[2] *= bflo(gw[1]); v0[3] *= bfhi(gw[1]);
          v1[0] *= bflo(gw[2]); v1[1] *= bfhi(gw[2]); v1[2] *= bflo(gw[3]); v1[3] *= bfhi(gw[3]);
          bf16_t* op = O + (size_t)tok * 1024 + c0 + bj * 128;
          if (PASS == 2) {
            const u32x4 tw = *(const u32x4*)op;
            v0[0] += bflo(tw[0]); v0[1] += bfhi(tw[0]); v0[2] += bflo(tw[1]); v0[3] += bfhi(tw[1]);
            v1[0] += bflo(tw[2]); v1[1] += bfhi(tw[2]); v1[2] += bflo(tw[3]); v1[3] += bfhi(tw[3]);
          }
          *(u32x4*)op = pack8(v0, v1);
        }
      }
  }
};

struct EpiMergeFused {
  static constexpr bool PERM = true, AFTER_DRAIN = false, MIDK = true;
  const bf16_t* gates; bf16_t* O;
  DI void mid(f32x4 (&acc)[2][2][4][2], const pg8::Unit& u, int wr, int wc, int fr_in, int fq_in) const {
    int fr = fr_in, fq = fq_in; asm volatile("" : "+v"(fr), "+v"(fq));
    const bf16_t* gR = gates + (size_t)T_TOK * 1024;
#pragma unroll
    for (int ai = 0; ai < 2; ++ai)
#pragma unroll
      for (int m = 0; m < 4; ++m) {
        const int tok = u.pm * 256 + ai * 128 + wr * 64 + m * 16 + fr;
        const int c0 = u.pn * 256 + wc * 32 + 8 * fq;
#pragma unroll
        for (int bj = 0; bj < 2; ++bj) {
          const u32x4 rw = *(const u32x4*)(gR + (size_t)tok * 1024 + c0 + bj * 128);
#pragma unroll
          for (int j = 0; j < 4; ++j) { acc[ai][bj][m][j >> 1][(j & 1) * 2] *= bflo(rw[j]); acc[ai][bj][m][j >> 1][(j & 1) * 2 + 1] *= bfhi(rw[j]); }
        }
      }
  }
  DI void operator()(const f32x4 (&acc)[2][2][4][2], const pg8::Unit& u, int wr, int wc, int fr_in, int fq_in) const {
    int fr = fr_in, fq = fq_in; asm volatile("" : "+v"(fr), "+v"(fq));
#pragma unroll
    for (int ai = 0; ai < 2; ++ai)
#pragma unroll
      for (int m = 0; m < 4; ++m) {
        const int tok = u.pm * 256 + ai * 128 + wr * 64 + m * 16 + fr;
        const int c0 = u.pn * 256 + wc * 32 + 8 * fq;
#pragma unroll
        for (int bj = 0; bj < 2; ++bj) {
          const u32x4 ga = *(const u32x4*)(gates + (size_t)tok * 1024 + c0 + bj * 128);
          f32x4 v0 = acc[ai][bj][m][0], v1 = acc[ai][bj][m][1];
          v0[0] *= fmaxf(bflo(ga[0]), 1e-20f); v0[1] *= fmaxf(bfhi(ga[0]), 1e-20f); v0[2] *= fmaxf(bflo(ga[1]), 1e-20f); v0[3] *= fmaxf(bfhi(ga[1]), 1e-20f);
          v1[0] *= fmaxf(bflo(ga[2]), 1e-20f); v1[1] *= fmaxf(bfhi(ga[2]), 1e-20f); v1[2] *= fmaxf(bflo(ga[3]), 1e-20f); v1[3] *= fmaxf(bfhi(ga[3]), 1e-20f);
          *(u32x4*)(O + (size_t)tok * 1024 + c0 + bj * 128) = pack8(v0, v1);
        }
      }
  }
};

template <class Epi>
DI void run_gemm(char* smem, const bf16_t* A, const bf16_t* Bt, int N, int K, const Epi& E) {
  pg8::Gemm g; g.A = A; g.Bt = Bt; g.M = T_TOK; g.N = N; g.K = K;
  int cblk = blockIdx.x; asm volatile("" : "+s"(cblk));
  pg8::StaticOrder S; S.init(T_TOK, N, gridDim.x, cblk);
  pg8::gemm_phase<Epi, pg8::StaticOrder, false>((PG8_LAS unsigned char*)smem, g, S, E, nullptr);
  __syncthreads();
}

DI void mixA_wave(const Params& p, int item, int lane) {
  char* ws = p.ws; asm volatile("" : "+s"(ws));
  const bf16_t* qa = (const bf16_t*)(ws + OFF_QA); const bf16_t* ka = (const bf16_t*)(ws + OFF_KA);
  const bf16_t* vaT = (const bf16_t*)(ws + OFF_VAT); bf16_t* Ya = (bf16_t*)(ws + OFF_YA);
  const int r = lane & 31, h = lane >> 5;
  const int bh = item & 63, qg = item >> 6;
  const int b = bh >> 3, hd = bh & 7;
  const int tq = qg * 32 + r;
  bf16x8 qf[4];
#pragma unroll
  for (int s = 0; s < 4; ++s) qf[s] = *(const bf16x8*)(qa + (size_t)(b * SEQ + tq) * 512 + hd * 64 + 16 * s + 8 * h);
  f32x16 o[2];
#pragma unroll
  for (int e = 0; e < 16; ++e) { o[0][e] = 0.f; o[1][e] = 0.f; }
  float carry = 0.f;
  const bf16_t* kcol = ka + (size_t)(b * SEQ + r) * 512 + hd * 64 + 8 * h;
  const bf16_t* vrow = vaT + ((size_t)((b * 8 + hd) * 64 + r)) * SEQ + 4 * h;
  bf16x8 kf[4];
#pragma unroll
  for (int s = 0; s < 4; ++s) kf[s] = *(const bf16x8*)(kcol + (size_t)(qg * 32) * 512 + 16 * s);
  for (int kt = qg; kt >= 0; --kt) {
    const int kbase = kt * 32;
    s16x4 vlo[2][2], vhi[2][2];
#pragma unroll
    for (int s2 = 0; s2 < 2; ++s2)
#pragma unroll
      for (int db = 0; db < 2; ++db) {
        const bf16_t* vp = vrow + (size_t)(32 * db) * SEQ + kbase + 16 * s2;
        vlo[s2][db] = *(const s16x4*)vp; vhi[s2][db] = *(const s16x4*)(vp + 8);
      }
    bf16x8 kn[4];
    const int knext = (kt > 0 ? kt - 1 : 0) * 32;
#pragma unroll
    for (int s = 0; s < 4; ++s) kn[s] = *(const bf16x8*)(kcol + (size_t)knext * 512 + 16 * s);
    f32x16 sacc;
#pragma unroll
    for (int e = 0; e < 16; ++e) sacc[e] = 0.f;
#pragma unroll
    for (int s = 0; s < 4; ++s) sacc = MFMA32(kf[s], qf[s], sacc);
    float z[16], L[16];
#pragma unroll
    for (int e = 0; e < 16; ++e) {
      z[e] = sacc[e] * 0.125f;
      const bool valid = (kbase + crow(e, h)) < tq;
      const float ex = __expf(-fabsf(z[e]));
      const float sp = fmaxf(z[e], 0.f) + __logf(1.0f + ex);
      L[e] = valid ? -sp : 0.f;
    }
    float G[4], Go[4];
#pragma unroll
    for (int g = 0; g < 4; ++g) { G[g] = (L[4 * g] + L[4 * g + 1]) + (L[4 * g + 2] + L[4 * g + 3]); Go[g] = __shfl_xor(G[g], 32); }
    float higher = 0.f;
    float a[16];
#pragma unroll
    for (int g = 3; g >= 0; --g) {
      const float base = carry + higher + (h == 0 ? Go[g] : 0.f);
      const float c3 = base + L[4 * g + 3];
      const float c2 = c3 + L[4 * g + 2];
      const float c1 = c2 + L[4 * g + 1];
      const float c0 = c1 + L[4 * g];
      const float cc[4] = {c0, c1, c2, c3};
#pragma unroll
      for (int rr = 0; rr < 4; ++rr) {
        const int e = 4 * g + rr;
        const bool valid = (kbase + crow(e, h)) < tq;
        a[e] = valid ? __expf(z[e] + cc[rr]) : 0.f;
      }
      higher += G[g] + Go[g];
    }
    carry += higher;
#pragma unroll
    for (int s2 = 0; s2 < 2; ++s2) {
      u32x4 pk;
#pragma unroll
      for (int j = 0; j < 4; ++j) pk[j] = pack2(a[8 * s2 + 2 * j], a[8 * s2 + 2 * j + 1]);
      const bf16x8 pf = __builtin_bit_cast(bf16x8, pk);
#pragma unroll
      for (int db = 0; db < 2; ++db) {
        const bf16x8 vf = __builtin_shufflevector(vlo[s2][db], vhi[s2][db], 0, 1, 2, 3, 4, 5, 6, 7);
        o[db] = MFMA32(vf, pf, o[db]);
      }
    }
#pragma unroll
    for (int s = 0; s < 4; ++s) kf[s] = kn[s];
    if (__ballot(carry < -60.0f) == ~0ull) break;
  }
#pragma unroll
  for (int db = 0; db < 2; ++db)
#pragma unroll
    for (int g = 0; g < 4; ++g) {
      u32x2 ov; ov[0] = pack2(o[db][4 * g], o[db][4 * g + 1]); ov[1] = pack2(o[db][4 * g + 2], o[db][4 * g + 3]);
      *(u32x2*)(Ya + (size_t)(b * SEQ + tq) * 1024 + 512 + hd * 64 + 32 * db + 8 * g + 4 * h) = ov;
    }
}

DI unsigned sortable(float v) {
  v = v + 0.0f;
  const unsigned u = __float_as_uint(v);
  return (u & 0x80000000u) ? ~u : (u | 0x80000000u);
}

typedef short s16x2_t __attribute__((ext_vector_type(2)));
DI float tile_score(const bf16x8& af, const bf16x8& kf, const s16x4& wa) {
  f32x4 ac = {0.f, 0.f, 0.f, 0.f};
  ac = MFMA16(af, kf, ac);
  const s16x2_t z2 = {0, 0};
  const s16x2_t r01 = __builtin_elementwise_max(__builtin_bit_cast(s16x2_t, pack2(ac[0], ac[1])), z2);
  const s16x2_t r23 = __builtin_elementwise_max(__builtin_bit_cast(s16x2_t, pack2(ac[2], ac[3])), z2);
  s16x4 rb; rb[0] = r01[0]; rb[1] = r01[1]; rb[2] = r23[0]; rb[3] = r23[1];
  f32x4 sc4 = {0.f, 0.f, 0.f, 0.f};
  sc4 = __builtin_amdgcn_mfma_f32_16x16x16bf16_1k(wa, rb, sc4, 0, 0, 0);
  return sc4[0];
}

DI int count_ge8(unsigned a0, unsigned a1, unsigned a2, unsigned a3, unsigned a4, unsigned a5, unsigned a6, unsigned a7, unsigned cand) {
  unsigned long long m0, m1, m2, m3, m4, m5, m6, m7;
  asm("v_cmp_ge_u32_e64 %0, %8, %16\n\tv_cmp_ge_u32_e64 %1, %9, %16\n\tv_cmp_ge_u32_e64 %2, %10, %16\n\tv_cmp_ge_u32_e64 %3, %11, %16\n\t"
      "v_cmp_ge_u32_e64 %4, %12, %16\n\tv_cmp_ge_u32_e64 %5, %13, %16\n\tv_cmp_ge_u32_e64 %6, %14, %16\n\tv_cmp_ge_u32_e64 %7, %15, %16"
      : "=s"(m0), "=s"(m1), "=s"(m2), "=s"(m3), "=s"(m4), "=s"(m5), "=s"(m6), "=s"(m7)
      : "v"(a0), "v"(a1), "v"(a2), "v"(a3), "v"(a4), "v"(a5), "v"(a6), "v"(a7), "v"(cand));
  return (__builtin_popcountll(m0) + __builtin_popcountll(m1)) + (__builtin_popcountll(m2) + __builtin_popcountll(m3))
       + (__builtin_popcountll(m4) + __builtin_popcountll(m5)) + (__builtin_popcountll(m6) + __builtin_popcountll(m7));
}

DI void count_ge8_pair(unsigned a0, unsigned a1, unsigned a2, unsigned a3, unsigned a4, unsigned a5, unsigned a6, unsigned a7, unsigned cand, int& ca, int& cb) {
  unsigned long long m0, m1, m2, m3, m4, m5, m6, m7;
  asm("v_cmp_ge_u32_e64 %0, %8, %16\n\tv_cmp_ge_u32_e64 %1, %9, %16\n\tv_cmp_ge_u32_e64 %2, %10, %16\n\tv_cmp_ge_u32_e64 %3, %11, %16\n\t"
      "v_cmp_ge_u32_e64 %4, %12, %16\n\tv_cmp_ge_u32_e64 %5, %13, %16\n\tv_cmp_ge_u32_e64 %6, %14, %16\n\tv_cmp_ge_u32_e64 %7, %15, %16"
      : "=s"(m0), "=s"(m1), "=s"(m2), "=s"(m3), "=s"(m4), "=s"(m5), "=s"(m6), "=s"(m7)
      : "v"(a0), "v"(a1), "v"(a2), "v"(a3), "v"(a4), "v"(a5), "v"(a6), "v"(a7), "v"(cand));
#define PCLO(m) __builtin_popcount((unsigned)(m))
#define PCHI(m) __builtin_popcount((unsigned)((m) >> 32))
  ca += (PCLO(m0) + PCLO(m1)) + (PCLO(m2) + PCLO(m3)) + (PCLO(m4) + PCLO(m5)) + (PCLO(m6) + PCLO(m7));
  cb += (PCHI(m0) + PCHI(m1)) + (PCHI(m2) + PCHI(m3)) + (PCHI(m4) + PCHI(m5)) + (PCHI(m6) + PCHI(m7));
}

DI void mixB_pair(const Params& p, int tokenA, char* smem, int lane, int w) {
  char* ws = p.ws; asm volatile("" : "+s"(ws));
  const bf16_t* qb = (const bf16_t*)(ws + OFF_QB); const bf16_t* kb = (const bf16_t*)(ws + OFF_KB);
  const bf16_t* vb = (const bf16_t*)(ws + OFF_VB); const bf16_t* qi = (const bf16_t*)(ws + OFF_QI);
  const bf16_t* ki = (const bf16_t*)(ws + OFF_KI); const float* wi = (const float*)(ws + OFF_WI);
  bf16_t* Yb = (bf16_t*)(ws + OFF_YA);
  char* wl_ = smem + w * WAVE_LDS;
  int* sidxA = (int*)wl_;
  int* sidxB = (int*)(wl_ + 16384);
  float* spl = (float*)(wl_ + 1024);
  bf16_t* pbf = (bf16_t*)(wl_ + 6144);
  char* vimg = wl_ + 8192;
  const int b = tokenA >> 12, pos = tokenA & 4095, qc = pos >> 6;
  const int nkeys = (qc + 1) * 64, nk64 = qc + 1;
  const int cntsel = nkeys <= 256 ? nkeys : 256;
  if (nkeys <= 256) {
    for (int s = lane; s < 256; s += 64) { const int v = (s < nkeys) ? s : 0; sidxA[s] = v; sidxB[s] = v; }
  } else {
    const int l15 = lane & 15, l4 = lane >> 4;
    const bool second = lane >= 32;
    const bf16x8 af = *(const bf16x8*)(qi + (size_t)(tokenA + (l15 >> 3)) * 256 + (l15 & 7) * 32 + 8 * l4);
    s16x4 wa;
    {
      const f32x4 wq = *(const f32x4*)(wi + (size_t)(tokenA + (l15 >> 3)) * 8 + 4 * (l4 & 1));
      const bool on = (l15 >> 3) == (l4 >> 1);
      u32x2 wp; wp[0] = on ? pack2(wq[0], wq[1]) : 0u; wp[1] = on ? pack2(wq[2], wq[3]) : 0u;
      wa = __builtin_bit_cast(s16x4, wp);
    }
    const char* kibase = (const char*)ki + (size_t)b * SEQ * 64;
    const unsigned kioff = (unsigned)(lane * 16);
    unsigned u[128];
#pragma unroll
    for (int i = 0; i < 128; ++i) u[i] = 0u;
#pragma unroll
    for (int c = 0; c < 16; ++c) {
      if (c * 4 < nk64) {
        bf16x8 kf[16];
#pragma unroll
        for (int t = 0; t < 16; ++t) kf[t] = *(const bf16x8*)(kibase + (size_t)(c * 16 + t) * 1024 + kioff);
#pragma unroll
        for (int rr = 0; rr < 8; ++rr) {
          const float s0 = tile_score(af, kf[2 * rr], wa), s1 = tile_score(af, kf[2 * rr + 1], wa);
          const float sv = (l4 & 1) ? s1 : s0;
          u[c * 8 + rr] = (c * 4 + (rr >> 1) < nk64) ? sortable(sv) : 0u;
        }
        __builtin_amdgcn_sched_barrier(0);
      }
    }
    unsigned thr = 0u;
    bool doneA = false, doneB = false;
    for (int bit = 31; bit >= 0; --bit) {
      const unsigned cand = thr | (1u << bit);
      int ca = 0, cb = 0;
#pragma unroll
      for (int c = 0; c < 8; ++c) {
        if (c * 8 < nk64) {
          count_ge8_pair(u[c * 16], u[c * 16 + 1], u[c * 16 + 2], u[c * 16 + 3], u[c * 16 + 4], u[c * 16 + 5], u[c * 16 + 6], u[c * 16 + 7], cand, ca, cb);
          count_ge8_pair(u[c * 16 + 8], u[c * 16 + 9], u[c * 16 + 10], u[c * 16 + 11], u[c * 16 + 12], u[c * 16 + 13], u[c * 16 + 14], u[c * 16 + 15], cand, ca, cb);
        }
      }
      const bool accA = ca >= 256, accB = cb >= 256;
      thr = (second ? accB : accA) ? cand : thr;
      doneA = doneA || (ca == 256); doneB = doneB || (cb == 256);
      if (doneA && doneB) break;
    }
    int* mylist = second ? sidxB : sidxA;
    const int keylo = 16 * (l4 & 1) + l15;
    int bA = 0, bB = 0;
#pragma unroll
    for (int c = 0; c < 16; ++c) {
      if (c * 4 < nk64) {
#pragma unroll
        for (int i = c * 8; i < c * 8 + 8; ++i) {
          const unsigned long long m = __ballot(u[i] > thr);
          const unsigned mlo = (unsigned)m, mhi = (unsigned)(m >> 32);
          const int plo = __builtin_popcount(mlo), phi = __builtin_popcount(mhi);
          const int pre = __builtin_amdgcn_mbcnt_hi(mhi, __builtin_amdgcn_mbcnt_lo(mlo, 0u)) - (second ? plo : 0);
          if (u[i] > thr) mylist[(second ? bB : bA) + pre] = 32 * i + keylo;
          bA += plo; bB += phi;
        }
      }
    }
    if (bA < 256 || bB < 256) {
      int eA = bA, eB = bB;
#pragma unroll
      for (int c = 0; c < 16; ++c) {
        if (c * 4 < nk64) {
#pragma unroll
          for (int i = c * 8; i < c * 8 + 8; ++i) {
            const unsigned long long m = __ballot(u[i] == thr);
            const unsigned mlo = (unsigned)m, mhi = (unsigned)(m >> 32);
            const int plo = __builtin_popcount(mlo), phi = __builtin_popcount(mhi);
            const int posn = (second ? eB : eA) + __builtin_amdgcn_mbcnt_hi(mhi, __builtin_amdgcn_mbcnt_lo(mlo, 0u)) - (second ? plo : 0);
            if (u[i] == thr && posn < 256) mylist[posn] = 32 * i + keylo;
            eA += plo; eB += phi;
          }
        }
      }
    }
  }
#pragma unroll 1
  for (int qsel = 0; qsel < 2; ++qsel) {
    const int token = tokenA + qsel;
    const int* sidx = qsel ? sidxB : sidxA;
  __builtin_amdgcn_fence(__ATOMIC_ACQ_REL, "wavefront");
  asm volatile("" : "+v"(lane));
  const int l15 = lane & 15, l4 = lane >> 4;
#pragma unroll 1
  for (int g = 0; g < 2; ++g) {
    bf16x8 qf0, qf1;
    {
      const bf16_t* qp = qb + (size_t)token * 512 + (g * 4 + (lane & 3)) * 64 + 8 * l4;
      qf0 = *(const bf16x8*)qp; qf1 = *(const bf16x8*)(qp + 32);
    }
    const char* kbbase = (const char*)kb + ((size_t)b * SEQ * 128 + g * 64) * 2;
    float mx[4] = {-INFINITY, -INFINITY, -INFINITY, -INFINITY};
    {
      const int ksl_ = lane >> 3, dch_ = lane & 7;
      u32x4 kk[32];
#pragma unroll
      for (int j = 0; j < 32; ++j) {
        const int key = sidx[j * 8 + ksl_];
        kk[j] = *(const u32x4*)(kbbase + (unsigned)(key * 256 + dch_ * 16));
      }
#pragma unroll
      for (int c = 0; c < 4; ++c) {
#pragma unroll
        for (int jj = 0; jj < 8; ++jj) {
          const int row = 8 * jj + ksl_;
          *(u32x4*)(vimg + row * 128 + ((dch_ ^ ((row >> 1) & 7)) * 16)) = kk[c * 8 + jj];
        }
        __builtin_amdgcn_fence(__ATOMIC_ACQ_REL, "wavefront");
#pragma unroll
        for (int tt = 0; tt < 4; ++tt) {
          const int t = c * 4 + tt;
          const int row = 16 * tt + l15, sw = (row >> 1) & 7;
          const bf16x8 k0 = *(const bf16x8*)(vimg + row * 128 + ((l4 ^ sw) * 16));
          const bf16x8 k1 = *(const bf16x8*)(vimg + row * 128 + (((4 + l4) ^ sw) * 16));
          f32x4 ac = {0.f, 0.f, 0.f, 0.f};
          ac = MFMA16(qf0, k0, ac);
          ac = MFMA16(qf1, k1, ac);
          const bool ok = (t * 16 + l15) < cntsel;
          f32x4 lgv;
#pragma unroll
          for (int i = 0; i < 4; ++i) { lgv[i] = ok ? ac[i] * 0.125f : -INFINITY; mx[i] = fmaxf(mx[i], lgv[i]); }
          float* dstp = (l4 == (t & 3)) ? (spl + (t * 16 + l15) * 4) : (spl + 1024 + lane * 4);
          *(f32x4*)dstp = lgv;
        }
        __builtin_amdgcn_fence(__ATOMIC_ACQ_REL, "wavefront");
      }
    }
    __builtin_amdgcn_sched_barrier(0);
    const int ksl = lane >> 3, dch = lane & 7;
    const char* vbase = (const char*)vb + ((size_t)b * SEQ * 128 + g * 64) * 2;
    u32x4 vv[32];
#pragma unroll
    for (int j = 0; j < 32; ++j) {
      const int key = sidx[j * 8 + ksl];
      vv[j] = *(const u32x4*)(vbase + (unsigned)(key * 256 + dch * 16));
    }
    __builtin_amdgcn_sched_barrier(0);
#pragma unroll
    for (int i = 0; i < 4; ++i) {
#pragma unroll
      for (int o = 1; o < 16; o <<= 1) mx[i] = fmaxf(mx[i], __shfl_xor(mx[i], o));
    }
    __builtin_amdgcn_fence(__ATOMIC_ACQ_REL, "wavefront");
    float sm[4] = {0.f, 0.f, 0.f, 0.f};
    {
      f32x4 lgq[4];
#pragma unroll
      for (int jj = 0; jj < 4; ++jj) lgq[jj] = *(const f32x4*)(spl + (4 * lane + jj) * 4);
#pragma unroll
      for (int i = 0; i < 4; ++i) {
        float pq[4];
#pragma unroll
        for (int jj = 0; jj < 4; ++jj) { pq[jj] = __expf(lgq[jj][i] - mx[i]); sm[i] += pq[jj]; }
        u32x2 w2; w2[0] = pack2(pq[0], pq[1]); w2[1] = pack2(pq[2], pq[3]);
        *(u32x2*)(pbf + i * 256 + 4 * lane) = w2;
      }
    }
#pragma unroll
    for (int i = 0; i < 4; ++i) {
#pragma unroll
      for (int o = 1; o < 64; o <<= 1) sm[i] += __shfl_xor(sm[i], o);
    }
    __builtin_amdgcn_fence(__ATOMIC_ACQ_REL, "wavefront");
    f32x4 oacc[4];
#pragma unroll
    for (int d = 0; d < 4; ++d) oacc[d] = (f32x4){0.f, 0.f, 0.f, 0.f};
    typedef __attribute__((address_space(3))) s16x4 lds_s16x4;
    const int tq = l15 >> 2, tp = l15 & 3;
#pragma unroll
    for (int c = 0; c < 4; ++c) {
#pragma unroll
      for (int jj = 0; jj < 8; ++jj) {
        const int row = 8 * jj + ksl, sw = ((row >> 1) & 1) | (((row >> 3) & 1) << 1);
        *(u32x4*)(vimg + row * 128 + ((dch ^ (sw << 1)) * 16)) = vv[c * 8 + jj];
      }
      __builtin_amdgcn_fence(__ATOMIC_ACQ_REL, "wavefront");
#pragma unroll
      for (int ks = 0; ks < 2; ++ks) {
        const bf16x8 pb = *(const bf16x8*)(pbf + (l15 & 3) * 256 + c * 64 + ks * 32 + 8 * l4);
#pragma unroll
        for (int d = 0; d < 4; ++d) {
          const int vrow_ = ks * 32 + 8 * l4 + tq, vsw_ = ((vrow_ >> 1) & 1) | (((vrow_ >> 3) & 1) << 1);
          const char* ap = vimg + vrow_ * 128 + (((d * 4 + tp) ^ (vsw_ << 2)) * 8);
          const s16x4 lo = __builtin_amdgcn_ds_read_tr16_b64_v4i16((lds_s16x4*)ap);
          const s16x4 hi = __builtin_amdgcn_ds_read_tr16_b64_v4i16((lds_s16x4*)(ap + 512));
          const bf16x8 va8 = __builtin_shufflevector(lo, hi, 0, 1, 2, 3, 4, 5, 6, 7);
          oacc[d] = MFMA16(va8, pb, oacc[d]);
        }
      }
      __builtin_amdgcn_fence(__ATOMIC_ACQ_REL, "wavefront");
    }
    {
      const int hd_ = l15 & 3;
      const float ssel = hd_ == 0 ? sm[0] : (hd_ == 1 ? sm[1] : (hd_ == 2 ? sm[2] : sm[3]));
      const float inv = __builtin_amdgcn_rcpf(ssel);
      if (l15 < 4) {
#pragma unroll
        for (int d = 0; d < 4; ++d) {
          u32x2 o; o[0] = pack2(oacc[d][0] * inv, oacc[d][1] * inv); o[1] = pack2(oacc[d][2] * inv, oacc[d][3] * inv);
          *(u32x2*)(Yb + (size_t)token * 1024 + (g * 4 + hd_) * 64 + d * 16 + 4 * l4) = o;
        }
      }
    }
    __builtin_amdgcn_fence(__ATOMIC_ACQ_REL, "wavefront");
  }

  }
}

DI void phase_mixers(const Params& p, char* smem) {
  const int tid = otid(), lane = tid & 63, w = __builtin_amdgcn_readfirstlane(tid >> 6);
  const int nwv = gridDim.x * NWAVE;
  const int wv = blockIdx.x * NWAVE + w;
  int itA = wv, jp = wv;
#pragma unroll 1
  for (int k = 0; itA < 64 * (SEQ / 32) || jp < T_TOK / 2; ++k) {
    if (itA < 64 * (SEQ / 32) && ((k & 1) == 0 || jp >= T_TOK / 2)) { mixA_wave(p, itA, lane); itA += nwv; }
    if (jp < T_TOK / 2) {
      const int bat = jp / (SEQ / 2), pidx = jp & (SEQ / 2 - 1);
      const int ppos = (bat & 1) ? (SEQ / 2 - 1 - pidx) : pidx;
      mixB_pair(p, bat * SEQ + 2 * ppos, smem, lane, w);
      jp += nwv;
    }
  }
  __syncthreads();
}

__global__ void __launch_bounds__(512) fwd_megakernel(Params p) {
  cg::grid_group grid = cg::this_grid();
  __shared__ __attribute__((aligned(1024))) char smem[LDS_BYTES];
  if (p.out == nullptr) grid.sync();
  __shared__ uint4 xb_words;
  if (otid() == 0) xb_words = make_uint4(0u, 0u, 0u, 0u);
  __syncthreads();
  const XcdBarrier xb = xcd_barrier_post((unsigned*)(p.ws + OFF_BAR), (volatile LAS unsigned*)&xb_words);
  phase_prep(p, smem);
  phase_rmsnorm<false, false>(p.x, p.g_mix, (bf16_t*)(p.ws + OFF_HBUF), nullptr);
  xcd_barrier(xb);
  bf16_t* xs = (bf16_t*)p.out;
#pragma unroll 1
  for (int layer = 0; layer < 2; ++layer) {
    char* wl = p.ws + (size_t)layer * WT_LAYER;
    bf16_t* hbuf = (bf16_t*)(p.ws + OFF_HBUF);
    if (layer > 0) {
      phase_rmsnorm<true, false>(xs, p.g_mix + DM, hbuf, nullptr);
      xcd_barrier(xb);
    }
    { EpiInproj E; E.ws = p.ws; run_gemm(smem, hbuf, (const bf16_t*)(wl + WT_IN), NPAD_IN, 1024, E); }
    xcd_barrier(xb);
    phase_mixers(p, smem);
    xcd_barrier(xb);
    { EpiMergeFused E; E.gates = (const bf16_t*)(p.ws + OFF_GATES); E.O = hbuf;
      run_gemm(smem, (const bf16_t*)(p.ws + OFF_YA), (const bf16_t*)(wl + WT_UPA), 1024, 1024, E); }
    xcd_barrier(xb);
    if (layer == 0) { EpiResid<true> E; E.R = p.x; E.O = xs; run_gemm(smem, hbuf, (const bf16_t*)(wl + WT_O), 1024, 1024, E); }
    else            { EpiResid<false> E; E.R = xs; E.O = xs; run_gemm(smem, hbuf, (const bf16_t*)(wl + WT_O), 1024, 1024, E); }
    xcd_barrier(xb);
    phase_rmsnorm<true, false>(xs, p.g_mlp + layer * DM, hbuf, nullptr);
    xcd_barrier(xb);
    { EpiSqrelu E; E.O = (bf16_t*)(p.ws + OFF_HIDDEN); run_gemm(smem, hbuf, (const bf16_t*)(wl + WT_FF1), 4096, 1024, E); }
    xcd_barrier(xb);
    { EpiResid<false> E; E.R = xs; E.O = layer == 0 ? xs : hbuf; run_gemm(smem, (const bf16_t*)(p.ws + OFF_HIDDEN), (const bf16_t*)(wl + WT_FF2), 1024, 4096, E); }
    xcd_barrier(xb);
  }
  phase_rmsnorm<true, true>((const bf16_t*)(p.ws + OFF_HBUF), p.g_final, nullptr, p.out);
}

extern "C" void kernel_launch(void* const* d_in, const int* in_sizes, int n_in,
                              void* d_out, int out_size, void* d_ws, size_t ws_size,
                              hipStream_t stream) {
  static int grid_blocks = 0;
  if (!grid_blocks) {
    int dev = 0, cus = 0, per_cu = 0;
    (void)hipGetDevice(&dev);
    (void)hipDeviceGetAttribute(&cus, hipDeviceAttributeMultiprocessorCount, dev);
    (void)hipOccupancyMaxActiveBlocksPerMultiprocessor(&per_cu, fwd_megakernel, NTHR, 0);
    if (per_cu > 1) per_cu = 1;
    if (per_cu < 1) per_cu = 1;
    grid_blocks = cus * per_cu;
  }
  Params p{};
  p.x = (const float*)d_in[0]; p.g_mix = (const float*)d_in[1]; p.w_in = (const float*)d_in[2];
  p.w_up_a = (const float*)d_in[3]; p.w_up_b = (const float*)d_in[4]; p.w_o = (const float*)d_in[5];
  p.g_mlp = (const float*)d_in[6]; p.w_ff1 = (const float*)d_in[7]; p.w_ff2 = (const float*)d_in[8];
  p.g_final = (const float*)d_in[9];
  p.out = (float*)d_out; p.ws = (char*)d_ws;
  (void)hipMemsetAsync((char*)d_ws + OFF_BAR, 0, XCD_BAR_WORDS * 4, stream);
  void* args[] = {&p};
  hipError_t e = hipLaunchCooperativeKernel((void*)fwd_megakernel, dim3(grid_blocks), dim3(NTHR), args, 0, stream);
  if (e != hipSuccess) fprintf(stderr, "cooperative launch failed: %s (grid %d)\n", hipGetErrorString(e), grid_blocks);
}
```

```cpp
#include <hip/hip_runtime.h>
#include <hip/hip_bf16.h>
#include <hip/hip_cooperative_groups.h>
#include <cstdio>
namespace cg = cooperative_groups;

#define DI __device__ __forceinline__
typedef __bf16 bf2_t __attribute__((ext_vector_type(2)));
typedef float fl2_t __attribute__((ext_vector_type(2)));
DI int otid() { int t = threadIdx.x; asm volatile("" : "+v"(t)); return t; }

#define XB_TMO      128
#define XB_XCNT(j)  (256  + 64 * (j))
#define XB_XSUB(j)  (1280 + 64 * (j))
#define XB_XGEN(j)  (2304 + 64 * (j))
#define XB_TOP      3328
#define XB_TOPGEN   3392
#define XCD_BAR_WORDS 3456
#define XB_SPIN_CAP (1u << 18)
#define LAS __attribute__((address_space(3)))

__device__ __forceinline__ unsigned xb_ld(unsigned* p)              { return __hip_atomic_load(p, __ATOMIC_RELAXED, __HIP_MEMORY_SCOPE_AGENT); }
__device__ __forceinline__ unsigned xb_add(unsigned* p, unsigned v) { return __hip_atomic_fetch_add(p, v, __ATOMIC_RELAXED, __HIP_MEMORY_SCOPE_AGENT); }
__device__ __forceinline__ unsigned xb_xcc_id() { return (unsigned)__builtin_amdgcn_s_getreg((3 << 11) | 20) & 0xFu; }
#define XB_SPIN(cond, bar) do { unsigned _sp = 0; while (cond) { __builtin_amdgcn_s_sleep(1); \
    if ((++_sp & 255u) == 0u) { if (xb_ld(&(bar)[XB_TMO])) break; if (_sp > XB_SPIN_CAP) { atomicAdd(&(bar)[XB_TMO], 1u); break; } } } } while (0)

struct XcdBarrier {
    unsigned* bar; unsigned x;
    volatile LAS unsigned* st;
};

__device__ __forceinline__ XcdBarrier xcd_barrier_post(unsigned* bar, volatile LAS unsigned* st) {
    XcdBarrier b; b.bar = bar; b.x = xb_xcc_id(); b.st = st;
    if (otid() == 0) (void)xb_add(&bar[XB_XCNT(b.x)], 1u);
    return b;
}
__device__ __forceinline__ void xcd_barrier_complete(unsigned* bar, unsigned x, unsigned& nloc, unsigned& nx) {
    const unsigned G = gridDim.x * gridDim.y * gridDim.z;
    unsigned sum, cnt, mine, sp = 0u;
    for (;;) {
        sum = 0u; cnt = 0u; mine = 0u;
#pragma unroll
        for (unsigned j = 0; j < 16; ++j) { const unsigned c = xb_ld(&bar[XB_XCNT(j)]); sum += c; cnt += (c > 0u) ? 1u : 0u; mine = (j == x) ? c : mine; }
        if (sum == G) break;
        __builtin_amdgcn_s_sleep(1);
        if ((++sp & 255u) == 0u) { if (xb_ld(&bar[XB_TMO])) break; if (sp > XB_SPIN_CAP) { atomicAdd(&bar[XB_TMO], 1u); break; } }
    }
    nloc = mine > 0u ? mine : 1u; nx = cnt > 0u ? cnt : 1u;
}

__device__ __forceinline__ void xcd_barrier(const XcdBarrier& b) {
    asm volatile("s_waitcnt vmcnt(0)" ::: "memory");
    __syncthreads();
    if (otid() == 0) {
        unsigned* bar = b.bar; unsigned bx_ = b.x;
        asm volatile("" : "+s"(bar), "+s"(bx_));
        __builtin_amdgcn_s_waitcnt(0);
        unsigned nloc = b.st[0], nx = b.st[1];
        if (nloc == 0u) { xcd_barrier_complete(bar, bx_, nloc, nx); b.st[0] = nloc; b.st[1] = nx; }
        const unsigned old = xb_add(&bar[XB_XSUB(bx_)], 1u);
        const unsigned gen = old / nloc;
        if (old + 1u == (gen + 1u) * nloc) {
            __builtin_amdgcn_fence(__ATOMIC_RELEASE, "agent");
            asm volatile("s_waitcnt vmcnt(0)" ::: "memory");
            const unsigned og = xb_add(&bar[XB_TOP], 1u);
            const unsigned tg = og / nx;
            if (og + 1u == (tg + 1u) * nx) xb_add(&bar[XB_TOPGEN], 1u);
            else XB_SPIN(xb_ld(&bar[XB_TOPGEN]) == tg, bar);
            __builtin_amdgcn_fence(__ATOMIC_ACQUIRE, "agent");
            xb_add(&bar[XB_XGEN(bx_)], 1u);
            asm volatile("s_waitcnt vmcnt(0)" ::: "memory");
        } else {
            XB_SPIN(xb_ld(&bar[XB_XGEN(bx_)]) == gen, bar);
            __builtin_amdgcn_fence(__ATOMIC_ACQUIRE, "agent");
            asm volatile("s_waitcnt vmcnt(0)" ::: "memory");
        }
    }
    __syncthreads();
}

namespace pg8 {
#define PG8_LAS __attribute__((address_space(3)))
typedef unsigned short bf16_t;
typedef short bf16x8 __attribute__((ext_vector_type(8)));
typedef float f32x4 __attribute__((ext_vector_type(4)));
typedef unsigned u32x4 __attribute__((ext_vector_type(4)));
constexpr int BM = 256, BK = 64, HALF = 128, HTB = HALF * BK * 2  , STAGE_BYTES = 8 * HTB, NXCD = 8, WGM = 8;

__host__ __device__ __forceinline__ int lds_byte(int r, int c) { const int st = (r >> 4) * 2 + (c >> 5), rr = r & 15, cc = c & 31, ob = rr * 64 + cc * 2; return st * 1024 + (ob ^ (((ob >> 9) & 1) << 5)); }
__host__ __device__ __forceinline__ void stage_rc(int b, int& R, int& C) { const int st = b / 1024, sb = b % 1024, swz = sb ^ (((sb >> 9) & 1) << 5); R = (st >> 1) * 16 + swz / 64; C = (st & 1) * 32 + (swz % 64) / 2; }
__host__ __device__ __forceinline__ int perm32(int rho) { const int n = rho >> 4, i = rho & 15; return 8 * (i >> 2) + 4 * n + (i & 3); }

struct Unit { int pm, pn; };
struct Gemm { const bf16_t* A; const bf16_t* Bt; int M, N, K; };
struct StaticOrder {
    int nM, nN, nwg, G, c;
    __host__ __device__ void init(int M, int N, int G_, int c_) { nM = M / BM; nN = N / BM; nwg = nM * nN; G = G_; c = c_; }
    __host__ __device__ bool next(int i, Unit& u) const {
        const long L = (long)i * G + c; if (L >= nwg) return false;
        int wgid = (int)L; { const int q = nwg / NXCD, r = nwg % NXCD, xcd = wgid % NXCD, off = wgid / NXCD; wgid = (xcd < r ? xcd * (q + 1) : r * (q + 1) + (xcd - r) * q) + off; }
        const int nig = WGM * nN, gid = wgid / nig, fm = gid * WGM, gsz = (nM - fm) < WGM ? (nM - fm) : WGM;
        u.pm = fm + ((wgid % nig) % gsz); u.pn = (wgid % nig) / gsz; return true;
    }
    __device__ __forceinline__ void a_ready(const Unit&) const {}
    __device__ __forceinline__ void done(const Unit&) const {}
};
template <class Epi, class Sched, bool STAMP = false>
__device__ __forceinline__ void gemm_phase(PG8_LAS unsigned char* lds, const Gemm g, const Sched& S, const Epi& E, unsigned long long* stamps) {
    const int tid = otid(), wid = __builtin_amdgcn_readfirstlane(tid >> 6), lane = tid & 63, wr = wid >> 2, wc = wid & 3, fr = lane & 15, fq = lane >> 4;
    const int K = g.K, nt = K / BK;
    int ts_lo = 0, ts_hi = 0, nts = 0; const unsigned long long rt_entry = STAMP ? (unsigned long long)wall_clock64() : 0ull;
#define PG8_STAMP() do { if (STAMP && wid == 0 && nts < 64) { const unsigned long long _c = (unsigned long long)clock64(); \
        ts_lo = (lane == nts) ? (int)(unsigned)_c : ts_lo; ts_hi = (lane == nts) ? (int)(unsigned)(_c >> 32) : ts_hi; ++nts; } } while (0)
    PG8_STAMP();
    unsigned voffA[2], voffB[2];
#pragma unroll
    for (int i = 0; i < 2; ++i) { int R, C; stage_rc(tid * 16 + i * 8192, R, C); const int Rb = Epi::PERM ? ((R & ~31) + perm32(R & 31)) : R;
        voffA[i] = (unsigned)(R * K + C) * 2u; voffB[i] = (unsigned)(Rb * K + C) * 2u; }
    const size_t kstep = (size_t)(BK * 2);
    const size_t hstep = (size_t)HALF * K * 2;
    const size_t tstep = 2 * hstep;
    const unsigned ldsw = (unsigned)wid * 1024u;
    const int aoff = lds_byte(wr * 64 + fr, fq * 8), boff = lds_byte(wc * 32 + fr, fq * 8);
#define PG8_SA(b, h) (((b) * 2 + (h)) * HTB)
#define PG8_SB(b, h) ((4 + (b) * 2 + (h)) * HTB)
#define PG8_STAGE(bufoff, gbase, voff) do { _Pragma("unroll") for (int _i = 0; _i < 2; ++_i) \
        __builtin_amdgcn_global_load_lds((const unsigned*)((const char*)(gbase) + (voff)[_i]), (PG8_LAS unsigned*)(lds + (bufoff) + ldsw + _i * 8192), 16, 0, 0); } while (0)
#define PG8_LDA(dst, b, h) do { _Pragma("unroll") for (int m = 0; m < 4; ++m) _Pragma("unroll") for (int k = 0; k < 2; ++k) dst[m][k] = *(const PG8_LAS bf16x8*)(lds + PG8_SA(b, h) + aoff + m * 2048 + k * 1024); } while (0)
#define PG8_LDB(dst, b, h) do { _Pragma("unroll") for (int n = 0; n < 2; ++n) _Pragma("unroll") for (int k = 0; k < 2; ++k) dst[n][k] = *(const PG8_LAS bf16x8*)(lds + PG8_SB(b, h) + boff + n * 2048 + k * 1024); } while (0)
#define PG8_MMA(ai, bj, At, Bt) do { __builtin_amdgcn_s_setprio(1); _Pragma("unroll") for (int m = 0; m < 4; ++m) _Pragma("unroll") for (int n = 0; n < 2; ++n) _Pragma("unroll") for (int k = 0; k < 2; ++k) \
        acc[ai][bj][m][n] = __builtin_amdgcn_mfma_f32_16x16x32_bf16(Bt[n][k], At[m][k], acc[ai][bj][m][n], 0, 0, 0); __builtin_amdgcn_s_setprio(0); } while (0)
#define PG8_WAIT_V(n) asm volatile("s_waitcnt vmcnt(" #n ")" ::: "memory")
#define PG8_WAIT_L(n) asm volatile("s_waitcnt lgkmcnt(" #n ")" ::: "memory")
#define PG8_BAR __builtin_amdgcn_s_barrier()
#define PG8_SCHED __builtin_amdgcn_sched_barrier(0)
    Unit cur, nxt; int ui = 0;
    if (!S.next(0, cur)) return;
    f32x4 acc[2][2][4][2];
#pragma unroll
    for (int a = 0; a < 2; ++a)
#pragma unroll
        for (int b = 0; b < 2; ++b)
#pragma unroll
            for (int m = 0; m < 4; ++m)
#pragma unroll
                for (int n = 0; n < 2; ++n) acc[a][b][m][n] = (f32x4){0.f, 0.f, 0.f, 0.f};
    bf16x8 At[4][2], B0[2][2], B1[2][2];
    const char* cA = (const char*)g.A + (size_t)cur.pm * tstep; const char* cB = (const char*)g.Bt + (size_t)cur.pn * tstep;
    S.a_ready(cur);
    PG8_STAGE(PG8_SB(0, 0), cB, voffB); PG8_STAGE(PG8_SA(0, 0), cA, voffA); PG8_STAGE(PG8_SB(0, 1), cB + hstep, voffB); PG8_STAGE(PG8_SA(0, 1), cA + hstep, voffA);
    if (wr == 1) PG8_BAR;
    PG8_WAIT_V(4); PG8_BAR;
    PG8_STAGE(PG8_SB(1, 0), cB + kstep, voffB); PG8_STAGE(PG8_SA(1, 0), cA + kstep, voffA); PG8_STAGE(PG8_SB(1, 1), cB + hstep + kstep, voffB);
    PG8_WAIT_V(6); PG8_BAR;
    PG8_STAMP();
    for (;;) {
        const bool has_next = S.next(ui + 1, nxt);
        const char* nA = has_next ? (const char*)g.A + (size_t)nxt.pm * tstep : cA; const char* nB = has_next ? (const char*)g.Bt + (size_t)nxt.pn * tstep : cB;
        for (int t = 0; t < nt; t += 2) {
            if constexpr (Epi::MIDK) { if (t == nt / 2) E.mid(acc, cur, wr, wc, fr, fq); }
            const bool last = (t == nt - 2);
            const char* a1 = cA + (size_t)(t + 1) * kstep;
            const char* a2 = last ? nA : cA + (size_t)(t + 2) * kstep; const char* b2 = last ? nB : cB + (size_t)(t + 2) * kstep;
            const char* a3 = a2 + kstep; const char* b3 = b2 + kstep;
            if (last && has_next) S.a_ready(nxt);
            PG8_LDB(B0, 0, 0); PG8_SCHED; PG8_LDA(At, 0, 0); PG8_STAGE(PG8_SA(1, 1), a1 + hstep, voffA);
            PG8_WAIT_L(8); PG8_BAR; PG8_WAIT_L(0); PG8_MMA(0, 0, At, B0); PG8_BAR; PG8_SCHED;
            PG8_LDB(B1, 0, 1); PG8_STAGE(PG8_SB(0, 0), b2, voffB);
            PG8_BAR; PG8_WAIT_L(0); PG8_MMA(0, 1, At, B1); PG8_BAR;
            PG8_LDA(At, 0, 1); PG8_STAGE(PG8_SA(0, 0), a2, voffA);
            PG8_BAR; PG8_WAIT_L(0); PG8_MMA(1, 0, At, B0); PG8_BAR; PG8_SCHED;
            PG8_STAGE(PG8_SB(0, 1), b2 + hstep, voffB);
            PG8_WAIT_V(6); PG8_BAR; PG8_MMA(1, 1, At, B1); PG8_BAR;
            PG8_LDB(B0, 1, 0); PG8_SCHED; PG8_LDA(At, 1, 0); PG8_STAGE(PG8_SA(0, 1), a2 + hstep, voffA);
            PG8_WAIT_L(8); PG8_BAR; PG8_WAIT_L(0); PG8_MMA(0, 0, At, B0); PG8_BAR; PG8_SCHED;
            PG8_LDB(B1, 1, 1); PG8_STAGE(PG8_SB(1, 0), b3, voffB);
            PG8_BAR; PG8_WAIT_L(0); PG8_MMA(0, 1, At, B1); PG8_BAR;
            PG8_LDA(At, 1, 1); PG8_STAGE(PG8_SA(1, 0), a3, voffA);
            PG8_BAR; PG8_WAIT_L(0); PG8_MMA(1, 0, At, B0); PG8_BAR; PG8_SCHED;
            PG8_STAGE(PG8_SB(1, 1), b3 + hstep, voffB);
            PG8_WAIT_V(6); PG8_BAR; PG8_MMA(1, 1, At, B1); PG8_BAR;
        }
        PG8_STAMP();
        if constexpr (!Epi::AFTER_DRAIN) { E(acc, cur, wr, wc, fr, fq); S.done(cur); }
        PG8_STAMP();
        if (!has_next) break;
#pragma unroll
        for (int a = 0; a < 2; ++a)
#pragma unroll
            for (int b = 0; b < 2; ++b)
#pragma unroll
                for (int m = 0; m < 4; ++m)
#pragma unroll
                    for (int n = 0; n < 2; ++n) acc[a][b][m][n] = (f32x4){0.f, 0.f, 0.f, 0.f};
        cur = nxt; cA = nA; cB = nB; ++ui;
    }
    PG8_WAIT_V(0);
    if (wr == 0) PG8_BAR;
    PG8_BAR;
    if constexpr (Epi::AFTER_DRAIN) { E.fused(acc, cur, wr, wc, fr, fq, lds, wid, lane); S.done(cur); }
    PG8_STAMP();
    if (STAMP && wid == 0) { stamps[lane] = lane < nts ? (((unsigned long long)(unsigned)ts_hi << 32) | (unsigned)ts_lo) : 0ull;
        if (lane == 62) stamps[62] = rt_entry; if (lane == 63) stamps[63] = (unsigned long long)wall_clock64(); }
#undef PG8_STAMP
#undef PG8_SA
#undef PG8_SB
#undef PG8_STAGE
#undef PG8_LDA
#undef PG8_LDB
#undef PG8_MMA
#undef PG8_WAIT_V
#undef PG8_WAIT_L
#undef PG8_BAR
#undef PG8_SCHED
}
}

typedef unsigned short bf16_t;
using bf16x8 = __attribute__((ext_vector_type(8))) short;
using s16x4  = __attribute__((ext_vector_type(4))) short;
using f32x16 = __attribute__((ext_vector_type(16))) float;
using f32x4  = __attribute__((ext_vector_type(4))) float;
using u32x4  = __attribute__((ext_vector_type(4))) unsigned;
using u32x2  = __attribute__((ext_vector_type(2))) unsigned;

#define MFMA32(a, b, c) __builtin_amdgcn_mfma_f32_32x32x16_bf16((a), (b), (c), 0, 0, 0)
#define MFMA16(a, b, c) __builtin_amdgcn_mfma_f32_16x16x32_bf16((a), (b), (c), 0, 0, 0)

constexpr int NTHR = 512, NWAVE = 8;
constexpr int T_TOK = 32768, SEQ = 4096, DM = 1024;
constexpr int NPAD_IN = 4864;
constexpr int SROW = 144;
constexpr int WAVE_LDS = 17408;
constexpr int LDS_BYTES = 8 * WAVE_LDS;

constexpr size_t WT_IN = 0;
constexpr size_t WT_UPA = WT_IN + (size_t)NPAD_IN * 1024 * 2;
constexpr size_t WT_UPB = WT_UPA + (size_t)1024 * 512 * 2;
constexpr size_t WT_O   = WT_UPB + (size_t)1024 * 512 * 2;
constexpr size_t WT_FF1 = WT_O + (size_t)1024 * 1024 * 2;
constexpr size_t WT_FF2 = WT_FF1 + (size_t)4096 * 1024 * 2;
constexpr size_t WT_LAYER = WT_FF2 + (size_t)1024 * 4096 * 2;
constexpr size_t OFF_ROPE = 2 * WT_LAYER;
constexpr size_t OFF_QA = OFF_ROPE + (size_t)SEQ * 24 * 4;
constexpr size_t OFF_KA = OFF_QA + (size_t)T_TOK * 512 * 2;
constexpr size_t OFF_VAT = OFF_KA + (size_t)T_TOK * 512 * 2;
constexpr size_t OFF_QB = OFF_VAT + (size_t)T_TOK * 512 * 2;
constexpr size_t OFF_KB = OFF_QB + (size_t)T_TOK * 512 * 2;
constexpr size_t OFF_VB = OFF_KB + (size_t)T_TOK * 128 * 2;
constexpr size_t OFF_QI = OFF_VB + (size_t)T_TOK * 128 * 2;
constexpr size_t OFF_KI = OFF_QI + (size_t)T_TOK * 256 * 2;
constexpr size_t OFF_WI = OFF_KI + (size_t)T_TOK * 32 * 2;
constexpr size_t OFF_GATES = OFF_WI + (size_t)T_TOK * 8 * 4;
constexpr size_t OFF_PROJ_END = OFF_GATES + (size_t)T_TOK * 2048 * 2;
constexpr size_t OFF_HIDDEN = OFF_QA;
constexpr size_t OFF_YA = OFF_PROJ_END;
constexpr size_t OFF_YB = OFF_YA + (size_t)T_TOK * 512 * 2;
constexpr size_t OFF_HBUF = OFF_YB + (size_t)T_TOK * 512 * 2;
constexpr size_t OFF_END = OFF_HBUF + (size_t)T_TOK * 1024 * 2;
constexpr size_t OFF_BAR = OFF_END;
static_assert(OFF_BAR + XCD_BAR_WORDS * 4 <= (size_t)512 * 1024 * 1024, "workspace too large");
static_assert(OFF_HIDDEN + (size_t)T_TOK * 4096 * 2 <= OFF_PROJ_END, "hidden alias");

struct Params {
  const float* x; const float* g_mix; const float* w_in; const float* w_up_a; const float* w_up_b;
  const float* w_o; const float* g_mlp; const float* w_ff1; const float* w_ff2; const float* g_final;
  float* out; char* ws;
};

DI unsigned pack2(float a, float b) {
  fl2_t f = {a, b};
  bf2_t r = __builtin_convertvector(f, bf2_t);
  return __builtin_bit_cast(unsigned, r);
}
DI bf16_t f2bf(float a) { return (bf16_t)(pack2(a, 0.f) & 0xffffu); }
DI float bflo(unsigned w) { return __uint_as_float(w << 16); }
DI float bfhi(unsigned w) { return __uint_as_float(w & 0xffff0000u); }
DI int crow(int reg, int h) { return (reg & 3) + 8 * (reg >> 2) + 4 * h; }
DI u32x4 pack8(const f32x4& a, const f32x4& b) {
  u32x4 w; w[0] = pack2(a[0], a[1]); w[1] = pack2(a[2], a[3]); w[2] = pack2(b[0], b[1]); w[3] = pack2(b[2], b[3]); return w;
}

DI int src_col(int nd, int mode) {
  if (!mode) return nd;
  if (nd < 2560) return nd;
  if (nd < 4608) { const int blk = (nd - 2560) >> 7; return 2600 + (blk & 1) * 1024 + (blk >> 1) * 128 + (nd & 127); }
  if (nd < 4648) return nd - 2048;
  return -1;
}
DI void convT(const float* __restrict__ W, int K, int N, bf16_t* __restrict__ WT, int NR, int mode, char* smem, int ldw = 0, int koff = 0) {
  if (ldw == 0) ldw = K;
  float* tile = (float*)smem;
  const int tid = otid();
  const int kt_n = K / 64, nt_n = NR / 64;
  for (int t = blockIdx.x; t < kt_n * nt_n; t += gridDim.x) {
    const int k0 = (t % kt_n) * 64, n0 = (t / kt_n) * 64;
    const int nl = tid & 63;
    const int sc = src_col(n0 + nl, mode);
    __syncthreads();
#pragma unroll
    for (int r = 0; r < 8; ++r) {
      const int kl = r * 8 + (tid >> 6);
      float v = 0.f;
      if (sc >= 0) v = W[(size_t)(k0 + kl) * N + sc];
      tile[kl * 65 + nl] = v;
    }
    __syncthreads();
    const int nrow = tid >> 3, ks = (tid & 7) * 8;
    u32x4 o0;
#pragma unroll
    for (int j = 0; j < 4; ++j) o0[j] = pack2(tile[(ks + 2 * j) * 65 + nrow], tile[(ks + 2 * j + 1) * 65 + nrow]);
    *(u32x4*)(WT + (size_t)(n0 + nrow) * ldw + koff + k0 + ks) = o0;
  }
}

DI void phase_prep(const Params& p, char* smem) {
  for (int l = 0; l < 2; ++l) {
    char* wl = p.ws + (size_t)l * WT_LAYER;
    convT(p.w_in + (size_t)l * 1024 * 4648, 1024, 4648, (bf16_t*)(wl + WT_IN), NPAD_IN, 1, smem);
    convT(p.w_up_b + (size_t)l * 512 * 1024, 512, 1024, (bf16_t*)(wl + WT_UPA), 1024, 0, smem, 1024, 0);
    convT(p.w_up_a + (size_t)l * 512 * 1024, 512, 1024, (bf16_t*)(wl + WT_UPA), 1024, 0, smem, 1024, 512);
    convT(p.w_o + (size_t)l * 1024 * 1024, 1024, 1024, (bf16_t*)(wl + WT_O), 1024, 0, smem);
    convT(p.w_ff1 + (size_t)l * 1024 * 4096, 1024, 4096, (bf16_t*)(wl + WT_FF1), 4096, 0, smem);
    convT(p.w_ff2 + (size_t)l * 4096 * 1024, 4096, 1024, (bf16_t*)(wl + WT_FF2), 1024, 0, smem);
  }
  float* rope = (float*)(p.ws + OFF_ROPE);
  for (int i = blockIdx.x * NTHR + otid(); i < SEQ * 12; i += gridDim.x * NTHR) {
    const int pos = i / 12, f = i % 12;
    float inv; int co, so;
    if (f < 8) { inv = powf(500000.0f, -((float)(2 * f) / 16.0f)); co = f; so = 8 + f; }
    else { inv = powf(500000.0f, -((float)(2 * (f - 8)) / 8.0f)); co = 16 + (f - 8); so = 20 + (f - 8); }
    const float ang = (float)pos * inv;
    float s, c; sincosf(ang, &s, &c);
    rope[pos * 24 + co] = c; rope[pos * 24 + so] = s;
  }
}

template <bool IN_BF, bool FINAL>
DI void phase_rmsnorm(const void* __restrict__ xin_, const float* __restrict__ g, bf16_t* __restrict__ hout, float* __restrict__ fout) {
  const int tid_ = otid(); const int wave = tid_ >> 6, lane = tid_ & 63;
  for (int t = blockIdx.x * NWAVE + wave; t < T_TOK; t += gridDim.x * NWAVE) {
    float v[16]; float ss = 0.f;
    if (IN_BF) {
      const u32x4* src = (const u32x4*)((const bf16_t*)xin_ + (size_t)t * DM);
#pragma unroll
      for (int i = 0; i < 2; ++i) {
        const u32x4 w4 = src[lane + 64 * i];
#pragma unroll
        for (int j = 0; j < 4; ++j) { v[8 * i + 2 * j] = bflo(w4[j]); v[8 * i + 2 * j + 1] = bfhi(w4[j]); }
      }
    } else {
      const float4* src = (const float4*)((const float*)xin_ + (size_t)t * DM);
#pragma unroll
      for (int i = 0; i < 4; ++i) { const float4 f = src[2 * lane + 128 * (i >> 1) + (i & 1)]; v[4 * i] = f.x; v[4 * i + 1] = f.y; v[4 * i + 2] = f.z; v[4 * i + 3] = f.w; }
    }
#pragma unroll
    for (int k = 0; k < 16; ++k) ss += v[k] * v[k];
#pragma unroll
    for (int o = 32; o > 0; o >>= 1) ss += __shfl_xor(ss, o);
    const float r = rsqrtf(ss * (1.0f / DM) + 1e-6f);
#pragma unroll
    for (int i = 0; i < 2; ++i) {
      const int e0 = (lane + 64 * i) * 8;
      const float4 g0 = *(const float4*)(g + e0), g1 = *(const float4*)(g + e0 + 4);
      float o8[8];
      o8[0] = v[8 * i] * r * g0.x; o8[1] = v[8 * i + 1] * r * g0.y; o8[2] = v[8 * i + 2] * r * g0.z; o8[3] = v[8 * i + 3] * r * g0.w;
      o8[4] = v[8 * i + 4] * r * g1.x; o8[5] = v[8 * i + 5] * r * g1.y; o8[6] = v[8 * i + 6] * r * g1.z; o8[7] = v[8 * i + 7] * r * g1.w;
      if (FINAL) {
        float4 a, b; a.x = o8[0]; a.y = o8[1]; a.z = o8[2]; a.w = o8[3]; b.x = o8[4]; b.y = o8[5]; b.z = o8[6]; b.w = o8[7];
        *(float4*)(fout + (size_t)t * DM + e0) = a; *(float4*)(fout + (size_t)t * DM + e0 + 4) = b;
      } else {
        u32x4 w4; w4[0] = pack2(o8[0], o8[1]); w4[1] = pack2(o8[2], o8[3]); w4[2] = pack2(o8[4], o8[5]); w4[3] = pack2(o8[6], o8[7]);
        *(u32x4*)(hout + (size_t)t * DM + e0) = w4;
      }
    }
  }
}


struct EpiInproj {
  static constexpr bool PERM = true, AFTER_DRAIN = false, MIDK = false;
  char* ws;
  DI void operator()(const f32x4 (&acc)[2][2][4][2], const pg8::Unit& u, int wr, int wc, int fr_in, int fq_in) const {
    int fr = fr_in, fq = fq_in; asm volatile("" : "+v"(fr), "+v"(fq));
    const float* rope = (const float*)(ws + OFF_ROPE);
    bf16_t* qa = (bf16_t*)(ws + OFF_QA); bf16_t* ka = (bf16_t*)(ws + OFF_KA); bf16_t* vaT = (bf16_t*)(ws + OFF_VAT);
    bf16_t* qb = (bf16_t*)(ws + OFF_QB); bf16_t* kb = (bf16_t*)(ws + OFF_KB); bf16_t* vb = (bf16_t*)(ws + OFF_VB);
    bf16_t* qi = (bf16_t*)(ws + OFF_QI); bf16_t* ki = (bf16_t*)(ws + OFF_KI); float* wi = (float*)(ws + OFF_WI);
    bf16_t* gates = (bf16_t*)(ws + OFF_GATES);
    const int cl8 = wc * 32 + 8 * fq;
    if (u.pn >= 10 && u.pn < 18) {
      bf16_t* gA = (bf16_t*)(ws + OFF_GATES); bf16_t* gR = gA + (size_t)T_TOK * 1024;
      const int ch0 = (u.pn - 10) * 128 + cl8;
#pragma unroll
      for (int ai = 0; ai < 2; ++ai)
#pragma unroll
        for (int m = 0; m < 4; ++m) {
          const int tok = u.pm * 256 + ai * 128 + wr * 64 + m * 16 + fr;
          f32x4 a0 = acc[ai][0][m][0], a1 = acc[ai][0][m][1], b0 = acc[ai][1][m][0], b1 = acc[ai][1][m][1];
#pragma unroll
          for (int j = 0; j < 4; ++j) {
            a0[j] = __builtin_amdgcn_rcpf(1.0f + __expf(-a0[j])); a1[j] = __builtin_amdgcn_rcpf(1.0f + __expf(-a1[j]));
            b0[j] = __builtin_amdgcn_rcpf(1.0f + __expf(-b0[j])); b1[j] = __builtin_amdgcn_rcpf(1.0f + __expf(-b1[j]));
          }
          const u32x4 wa4 = pack8(a0, a1);
          *(u32x4*)(gA + (size_t)tok * 1024 + ch0) = wa4;
          f32x4 r0, r1;
          r0[0] = b0[0] * __builtin_amdgcn_rcpf(fmaxf(bflo(wa4[0]), 1e-20f)); r0[1] = b0[1] * __builtin_amdgcn_rcpf(fmaxf(bfhi(wa4[0]), 1e-20f));
          r0[2] = b0[2] * __builtin_amdgcn_rcpf(fmaxf(bflo(wa4[1]), 1e-20f)); r0[3] = b0[3] * __builtin_amdgcn_rcpf(fmaxf(bfhi(wa4[1]), 1e-20f));
          r1[0] = b1[0] * __builtin_amdgcn_rcpf(fmaxf(bflo(wa4[2]), 1e-20f)); r1[1] = b1[1] * __builtin_amdgcn_rcpf(fmaxf(bfhi(wa4[2]), 1e-20f));
          r1[2] = b1[2] * __builtin_amdgcn_rcpf(fmaxf(bflo(wa4[3]), 1e-20f)); r1[3] = b1[3] * __builtin_amdgcn_rcpf(fmaxf(bfhi(wa4[3]), 1e-20f));
          *(u32x4*)(gR + (size_t)tok * 1024 + ch0) = pack8(r0, r1);
        }
      return;
    }
#pragma unroll
    for (int bj = 0; bj < 2; ++bj) {
      const int ni = u.pn * 2 + bj;
      if (ni >= 37) continue;
#pragma unroll
      for (int ai = 0; ai < 2; ++ai)
#pragma unroll
        for (int m = 0; m < 4; ++m) {
          const int tok = u.pm * 256 + ai * 128 + wr * 64 + m * 16 + fr;
          const int pos = tok & 4095;
          f32x4 v0 = acc[ai][bj][m][0], v1 = acc[ai][bj][m][1];
          if (ni < 8) {
            bf16_t* dst = (ni < 4) ? qa : ka;
            *(u32x4*)(dst + (size_t)tok * 512 + (ni & 3) * 128 + cl8) = pack8(v0, v1);
          } else if (ni < 12) {
            const int c = (ni - 8) * 128 + cl8; const int hd = c >> 6, d = c & 63; const int b = tok >> 12;
            bf16_t* dst = vaT + ((size_t)((b * 8 + hd) * 64 + d)) * SEQ + pos;
#pragma unroll
            for (int j = 0; j < 4; ++j) { dst[(size_t)j * SEQ] = f2bf(v0[j]); dst[(size_t)(j + 4) * SEQ] = f2bf(v1[j]); }
          } else if (ni < 17) {
            const int d0 = cl8 & 63;
            f32x4 p0, p1;
#pragma unroll
            for (int j = 0; j < 4; ++j) { p0[j] = __shfl_xor(v0[j], 16); p1[j] = __shfl_xor(v1[j], 16); }
            if (d0 < 16) {
              const f32x4 c0 = *(const f32x4*)(rope + pos * 24), c1 = *(const f32x4*)(rope + pos * 24 + 4);
              const f32x4 s0 = *(const f32x4*)(rope + pos * 24 + 8), s1 = *(const f32x4*)(rope + pos * 24 + 12);
              if (d0 == 0) { v0 = v0 * c0 - p0 * s0; v1 = v1 * c1 - p1 * s1; }
              else         { v0 = v0 * c0 + p0 * s0; v1 = v1 * c1 + p1 * s1; }
            }
            if (ni < 16) *(u32x4*)(qb + (size_t)tok * 512 + (ni - 12) * 128 + cl8) = pack8(v0, v1);
            else         *(u32x4*)(kb + (size_t)tok * 128 + cl8) = pack8(v0, v1);
          } else if (ni == 17) {
            *(u32x4*)(vb + (size_t)tok * 128 + cl8) = pack8(v0, v1);
          } else if (ni < 20 || ni == 36) {
            if ((cl8 & 31) == 0 && (ni < 20 || cl8 == 0)) {
              const f32x4 cs = *(const f32x4*)(rope + pos * 24 + 16), sn = *(const f32x4*)(rope + pos * 24 + 20);
              const f32x4 a = v0 * cs - v1 * sn, b2 = v1 * cs + v0 * sn;
              v0 = a; v1 = b2;
            }
            if (ni < 20) *(u32x4*)(qi + (size_t)tok * 256 + (ni - 18) * 128 + cl8) = pack8(v0, v1);
            else if (cl8 < 32) *(u32x4*)(ki + (size_t)(tok >> 4) * 512 + (cl8 >> 3) * 128 + (tok & 15) * 8) = pack8(v0, v1);
            else if (cl8 == 32) { *(f32x4*)(wi + (size_t)tok * 8) = v0 * 0.0625f; *(f32x4*)(wi + (size_t)tok * 8 + 4) = v1 * 0.0625f; }
          } else {
#pragma unroll
            for (int j = 0; j < 4; ++j) { v0[j] = __builtin_amdgcn_rcpf(1.0f + __expf(-v0[j])); v1[j] = __builtin_amdgcn_rcpf(1.0f + __expf(-v1[j])); }
            *(u32x4*)(gates + (size_t)tok * 2048 + (ni - 20) * 128 + cl8) = pack8(v0, v1);
          }
        }
    }
  }
};

struct EpiSqrelu {
  static constexpr bool PERM = true, AFTER_DRAIN = false, MIDK = false;
  bf16_t* O;
  DI void operator()(const f32x4 (&acc)[2][2][4][2], const pg8::Unit& u, int wr, int wc, int fr_in, int fq_in) const {
    int fr = fr_in, fq = fq_in; asm volatile("" : "+v"(fr), "+v"(fq));
#pragma unroll
    for (int ai = 0; ai < 2; ++ai)
#pragma unroll
      for (int m = 0; m < 4; ++m) {
        bf16_t* rowp = O + (size_t)(u.pm * 256 + ai * 128 + wr * 64 + m * 16 + fr) * 4096 + u.pn * 256 + wc * 32 + 8 * fq;
#pragma unroll
        for (int bj = 0; bj < 2; ++bj) {
          f32x4 v0 = acc[ai][bj][m][0], v1 = acc[ai][bj][m][1];
#pragma unroll
          for (int j = 0; j < 4; ++j) { const float a = fmaxf(v0[j], 0.f), b = fmaxf(v1[j], 0.f); v0[j] = a * a; v1[j] = b * b; }
          __builtin_nontemporal_store(pack8(v0, v1), (u32x4*)(rowp + bj * 128));
        }
      }
  }
};

template <bool RF32>
struct EpiResid {
  static constexpr bool PERM = true, AFTER_DRAIN = false, MIDK = false;
  const void* R; bf16_t* O;
  DI void operator()(const f32x4 (&acc)[2][2][4][2], const pg8::Unit& u, int wr, int wc, int fr_in, int fq_in) const {
    int fr = fr_in, fq = fq_in; asm volatile("" : "+v"(fr), "+v"(fq));
#pragma unroll
    for (int ai = 0; ai < 2; ++ai)
#pragma unroll
      for (int m = 0; m < 4; ++m) {
        const size_t ro = (size_t)(u.pm * 256 + ai * 128 + wr * 64 + m * 16 + fr) * 1024 + u.pn * 256 + wc * 32 + 8 * fq;
#pragma unroll
        for (int bj = 0; bj < 2; ++bj) {
          const size_t o = ro + bj * 128;
          f32x4 v0 = acc[ai][bj][m][0], v1 = acc[ai][bj][m][1];
          if (RF32) { v0 += *(const f32x4*)((const float*)R + o); v1 += *(const f32x4*)((const float*)R + o + 4); }
          else {
            const u32x4 rw = *(const u32x4*)((const bf16_t*)R + o);
            v0[0] += bflo(rw[0]); v0[1] += bfhi(rw[0]); v0[2] += bflo(rw[1]); v0[3] += bfhi(rw[1]);
            v1[0] += bflo(rw[2]); v1[1] += bfhi(rw[2]); v1[2] += bflo(rw[3]); v1[3] += bfhi(rw[3]);
          }
          *(u32x4*)(O + o) = pack8(v0, v1);
        }
      }
  }
};

template <int PASS>
struct EpiMerge {
  static constexpr bool PERM = true, AFTER_DRAIN = false, MIDK = false;
  const bf16_t* gates; bf16_t* O;
  DI void operator()(const f32x4 (&acc)[2][2][4][2], const pg8::Unit& u, int wr, int wc, int fr_in, int fq_in) const {
    int fr = fr_in, fq = fq_in; asm volatile("" : "+v"(fr), "+v"(fq));
#pragma unroll
    for (int ai = 0; ai < 2; ++ai)
#pragma unroll
      for (int m = 0; m < 4; ++m) {
        const int tok = u.pm * 256 + ai * 128 + wr * 64 + m * 16 + fr;
        const int c0 = u.pn * 256 + wc * 32 + 8 * fq;
#pragma unroll
        for (int bj = 0; bj < 2; ++bj) {
          const u32x4 gw = *(const u32x4*)(gates + (size_t)tok * 2048 + (PASS == 1 ? 1024 : 0) + c0 + bj * 128);
          f32x4 v0 = acc[ai][bj][m][0], v1 = acc[ai][bj][m][1];
          v0[0] *= bflo(gw[0]); v0[1] *= bfhi(gw[0]); v0[2] *= bflo(gw[1]); v0[3] *= bfhi(gw[1]);
          v1[0] *= bflo(gw[2]); v1[1] *= bfhi(gw[2]); v1[2] *= bflo(gw[3]); v1[3] *= bfhi(gw[3]);
          bf16_t* op = O + (size_t)tok * 1024 + c0 + bj * 128;
          if (PASS == 2) {
            const u32x4 tw = *(const u32x4*)op;
            v0[0] += bflo(tw[0]); v0[1] += bfhi(tw[0]); v0[2] += bflo(tw[1]); v0[3] += bfhi(tw[1]);
            v1[0] += bflo(tw[2]); v1[1] += bfhi(tw[2]); v1[2] += bflo(tw[3]); v1[3] += bfhi(tw[3]);
          }
          *(u32x4*)op = pack8(v0, v1);
        }
      }
  }
};

struct EpiMergeFused {
  static constexpr bool PERM = true, AFTER_DRAIN = false, MIDK = true;
  const bf16_t* gates; bf16_t* O;
  DI void mid(f32x4 (&acc)[2][2][4][2], const pg8::Unit& u, int wr, int wc, int fr_in, int fq_in) const {
    int fr = fr_in, fq = fq_in; asm volatile("" : "+v"(fr), "+v"(fq));
    const bf16_t* gR = gates + (size_t)T_TOK * 1024;
#pragma unroll
    for (int ai = 0; ai < 2; ++ai)
#pragma unroll
      for (int m = 0; m < 4; ++m) {
        const int tok = u.pm * 256 + ai * 128 + wr * 64 + m * 16 + fr;
        const int c0 = u.pn * 256 + wc * 32 + 8 * fq;
#pragma unroll
        for (int bj = 0; bj < 2; ++bj) {
          const u32x4 rw = *(const u32x4*)(gR + (size_t)tok * 1024 + c0 + bj * 128);
#pragma unroll
          for (int j = 0; j < 4; ++j) { acc[ai][bj][m][j >> 1][(j & 1) * 2] *= bflo(rw[j]); acc[ai][bj][m][j >> 1][(j & 1) * 2 + 1] *= bfhi(rw[j]); }
        }
      }
  }
  DI void operator()(const f32x4 (&acc)[2][2][4][2], const pg8::Unit& u, int wr, int wc, int fr_in, int fq_in) const {
    int fr = fr_in, fq = fq_in; asm volatile("" : "+v"(fr), "+v"(fq));
#pragma unroll
    for (int ai = 0; ai < 2; ++ai)
#pragma unroll
      for (int m = 0; m < 4; ++m) {
        const int tok = u.pm * 256 + ai * 128 + wr * 64 + m * 16 + fr;
        const int c0 = u.pn * 256 + wc * 32 + 8 * fq;
#pragma unroll
        for (int bj = 0; bj < 2; ++bj) {
          const u32x4 ga = *(const u32x4*)(gates + (size_t)tok * 1024 + c0 + bj * 128);
          f32x4 v0 = acc[ai][bj][m][0], v1 = acc[ai][bj][m][1];
          v0[0] *= fmaxf(bflo(ga[0]), 1e-20f); v0[1] *= fmaxf(bfhi(ga[0]), 1e-20f); v0[2] *= fmaxf(bflo(ga[1]), 1e-20f); v0[3] *= fmaxf(bfhi(ga[1]), 1e-20f);
          v1[0] *= fmaxf(bflo(ga[2]), 1e-20f); v1[1] *= fmaxf(bfhi(ga[2]), 1e-20f); v1[2] *= fmaxf(bflo(ga[3]), 1e-20f); v1[3] *= fmaxf(bfhi(ga[3]), 1e-20f);
          *(u32x4*)(O + (size_t)tok * 1024 + c0 + bj * 128) = pack8(v0, v1);
        }
      }
  }
};

template <class Epi>
DI void run_gemm(char* smem, const bf16_t* A, const bf16_t* Bt, int N, int K, const Epi& E) {
  pg8::Gemm g; g.A = A; g.Bt = Bt; g.M = T_TOK; g.N = N; g.K = K;
  int cblk = blockIdx.x; asm volatile("" : "+s"(cblk));
  pg8::StaticOrder S; S.init(T_TOK, N, gridDim.x, cblk);
  pg8::gemm_phase<Epi, pg8::StaticOrder, false>((PG8_LAS unsigned char*)smem, g, S, E, nullptr);
  __syncthreads();
}

DI void mixA_wave(const Params& p, int item, int lane) {
  char* ws = p.ws; asm volatile("" : "+s"(ws));
  const bf16_t* qa = (const bf16_t*)(ws + OFF_QA); const bf16_t* ka = (const bf16_t*)(ws + OFF_KA);
  const bf16_t* vaT = (const bf16_t*)(ws + OFF_VAT); bf16_t* Ya = (bf16_t*)(ws + OFF_YA);
  const int r = lane & 31, h = lane >> 5;
  const int bh = item & 63, qg = item >> 6;
  const int b = bh >> 3, hd = bh & 7;
  const int tq = qg * 32 + r;
  bf16x8 qf[4];
#pragma unroll
  for (int s = 0; s < 4; ++s) qf[s] = *(const bf16x8*)(qa + (size_t)(b * SEQ + tq) * 512 + hd * 64 + 16 * s + 8 * h);
  f32x16 o[2];
#pragma unroll
  for (int e = 0; e < 16; ++e) { o[0][e] = 0.f; o[1][e] = 0.f; }
  float carry = 0.f;
  const bf16_t* kcol = ka + (size_t)(b * SEQ + r) * 512 + hd * 64 + 8 * h;
  const bf16_t* vrow = vaT + ((size_t)((b * 8 + hd) * 64 + r)) * SEQ + 4 * h;
  bf16x8 kf[4];
#pragma unroll
  for (int s = 0; s < 4; ++s) kf[s] = *(const bf16x8*)(kcol + (size_t)(qg * 32) * 512 + 16 * s);
  for (int kt = qg; kt >= 0; --kt) {
    const int kbase = kt * 32;
    s16x4 vlo[2][2], vhi[2][2];
#pragma unroll
    for (int s2 = 0; s2 < 2; ++s2)
#pragma unroll
      for (int db = 0; db < 2; ++db) {
        const bf16_t* vp = vrow + (size_t)(32 * db) * SEQ + kbase + 16 * s2;
        vlo[s2][db] = *(const s16x4*)vp; vhi[s2][db] = *(const s16x4*)(vp + 8);
      }
    bf16x8 kn[4];
    const int knext = (kt > 0 ? kt - 1 : 0) * 32;
#pragma unroll
    for (int s = 0; s < 4; ++s) kn[s] = *(const bf16x8*)(kcol + (size_t)knext * 512 + 16 * s);
    f32x16 sacc;
#pragma unroll
    for (int e = 0; e < 16; ++e) sacc[e] = 0.f;
#pragma unroll
    for (int s = 0; s < 4; ++s) sacc = MFMA32(kf[s], qf[s], sacc);
    float z[16], L[16];
#pragma unroll
    for (int e = 0; e < 16; ++e) {
      z[e] = sacc[e] * 0.125f;
      const bool valid = (kbase + crow(e, h)) < tq;
      const float ex = __expf(-fabsf(z[e]));
      const float sp = fmaxf(z[e], 0.f) + __logf(1.0f + ex);
      L[e] = valid ? -sp : 0.f;
    }
    float G[4], Go[4];
#pragma unroll
    for (int g = 0; g < 4; ++g) { G[g] = (L[4 * g] + L[4 * g + 1]) + (L[4 * g + 2] + L[4 * g + 3]); Go[g] = __shfl_xor(G[g], 32); }
    float higher = 0.f;
    float a[16];
#pragma unroll
    for (int g = 3; g >= 0; --g) {
      const float base = carry + higher + (h == 0 ? Go[g] : 0.f);
      const float c3 = base + L[4 * g + 3];
      const float c2 = c3 + L[4 * g + 2];
      const float c1 = c2 + L[4 * g + 1];
      const float c0 = c1 + L[4 * g];
      const float cc[4] = {c0, c1, c2, c3};
#pragma unroll
      for (int rr = 0; rr < 4; ++rr) {
        const int e = 4 * g + rr;
        const bool valid = (kbase + crow(e, h)) < tq;
        a[e] = valid ? __expf(z[e] + cc[rr]) : 0.f;
      }
      higher += G[g] + Go[g];
    }
    carry += higher;
#pragma unroll
    for (int s2 = 0; s2 < 2; ++s2) {
      u32x4 pk;
#pragma unroll
      for (int j = 0; j < 4; ++j) pk[j] = pack2(a[8 * s2 + 2 * j], a[8 * s2 + 2 * j + 1]);
      const bf16x8 pf = __builtin_bit_cast(bf16x8, pk);
#pragma unroll
      for (int db = 0; db < 2; ++db) {
        const bf16x8 vf = __builtin_shufflevector(vlo[s2][db], vhi[s2][db], 0, 1, 2, 3, 4, 5, 6, 7);
        o[db] = MFMA32(vf, pf, o[db]);
      }
    }
#pragma unroll
    for (int s = 0; s < 4; ++s) kf[s] = kn[s];
    if (__ballot(carry < -60.0f) == ~0ull) break;
  }
#pragma unroll
  for (int db = 0; db < 2; ++db)
#pragma unroll
    for (int g = 0; g < 4; ++g) {
      u32x2 ov; ov[0] = pack2(o[db][4 * g], o[db][4 * g + 1]); ov[1] = pack2(o[db][4 * g + 2], o[db][4 * g + 3]);
      *(u32x2*)(Ya + (size_t)(b * SEQ + tq) * 1024 + 512 + hd * 64 + 32 * db + 8 * g + 4 * h) = ov;
    }
}

DI unsigned sortable(float v) {
  v = v + 0.0f;
  const unsigned u = __float_as_uint(v);
  return (u & 0x80000000u) ? ~u : (u | 0x80000000u);
}

typedef short s16x2_t __attribute__((ext_vector_type(2)));
DI float tile_score(const bf16x8& af, const bf16x8& kf, const s16x4& wa) {
  f32x4 ac = {0.f, 0.f, 0.f, 0.f};
  ac = MFMA16(af, kf, ac);
  const s16x2_t z2 = {0, 0};
  const s16x2_t r01 = __builtin_elementwise_max(__builtin_bit_cast(s16x2_t, pack2(ac[0], ac[1])), z2);
  const s16x2_t r23 = __builtin_elementwise_max(__builtin_bit_cast(s16x2_t, pack2(ac[2], ac[3])), z2);
  s16x4 rb; rb[0] = r01[0]; rb[1] = r01[1]; rb[2] = r23[0]; rb[3] = r23[1];
  f32x4 sc4 = {0.f, 0.f, 0.f, 0.f};
  sc4 = __builtin_amdgcn_mfma_f32_16x16x16bf16_1k(wa, rb, sc4, 0, 0, 0);
  return sc4[0];
}

DI int count_ge8(unsigned a0, unsigned a1, unsigned a2, unsigned a3, unsigned a4, unsigned a5, unsigned a6, unsigned a7, unsigned cand) {
  unsigned long long m0, m1, m2, m3, m4, m5, m6, m7;
  asm("v_cmp_ge_u32_e64 %0, %8, %16\n\tv_cmp_ge_u32_e64 %1, %9, %16\n\tv_cmp_ge_u32_e64 %2, %10, %16\n\tv_cmp_ge_u32_e64 %3, %11, %16\n\t"
      "v_cmp_ge_u32_e64 %4, %12, %16\n\tv_cmp_ge_u32_e64 %5, %13, %16\n\tv_cmp_ge_u32_e64 %6, %14, %16\n\tv_cmp_ge_u32_e64 %7, %15, %16"
      : "=s"(m0), "=s"(m1), "=s"(m2), "=s"(m3), "=s"(m4), "=s"(m5), "=s"(m6), "=s"(m7)
      : "v"(a0), "v"(a1), "v"(a2), "v"(a3), "v"(a4), "v"(a5), "v"(a6), "v"(a7), "v"(cand));
  return (__builtin_popcountll(m0) + __builtin_popcountll(m1)) + (__builtin_popcountll(m2) + __builtin_popcountll(m3))
       + (__builtin_popcountll(m4) + __builtin_popcountll(m5)) + (__builtin_popcountll(m6) + __builtin_popcountll(m7));
}

DI void count_ge8_pair(unsigned a0, unsigned a1, unsigned a2, unsigned a3, unsigned a4, unsigned a5, unsigned a6, unsigned a7, unsigned cand, int& ca, int& cb) {
  unsigned long long m0, m1, m2, m3, m4, m5, m6, m7;
  asm("v_cmp_ge_u32_e64 %0, %8, %16\n\tv_cmp_ge_u32_e64 %1, %9, %16\n\tv_cmp_ge_u32_e64 %2, %10, %16\n\tv_cmp_ge_u32_e64 %3, %11, %16\n\t"
      "v_cmp_ge_u32_e64 %4, %12, %16\n\tv_cmp_ge_u32_e64 %5, %13, %16\n\tv_cmp_ge_u32_e64 %6, %14, %16\n\tv_cmp_ge_u32_e64 %7, %15, %16"
      : "=s"(m0), "=s"(m1), "=s"(m2), "=s"(m3), "=s"(m4), "=s"(m5), "=s"(m6), "=s"(m7)
      : "v"(a0), "v"(a1), "v"(a2), "v"(a3), "v"(a4), "v"(a5), "v"(a6), "v"(a7), "v"(cand));
#define PCLO(m) __builtin_popcount((unsigned)(m))
#define PCHI(m) __builtin_popcount((unsigned)((m) >> 32))
  ca += (PCLO(m0) + PCLO(m1)) + (PCLO(m2) + PCLO(m3)) + (PCLO(m4) + PCLO(m5)) + (PCLO(m6) + PCLO(m7));
  cb += (PCHI(m0) + PCHI(m1)) + (PCHI(m2) + PCHI(m3)) + (PCHI(m4) + PCHI(m5)) + (PCHI(m6) + PCHI(m7));
}

DI void mixB_pair(const Params& p, int tokenA, char* smem, int lane, int w) {
  char* ws = p.ws; asm volatile("" : "+s"(ws));
  const bf16_t* qb = (const bf16_t*)(ws + OFF_QB); const bf16_t* kb = (const bf16_t*)(ws + OFF_KB);
  const bf16_t* vb = (const bf16_t*)(ws + OFF_VB); const bf16_t* qi = (const bf16_t*)(ws + OFF_QI);
  const bf16_t* ki = (const bf16_t*)(ws + OFF_KI); const float* wi = (const float*)(ws + OFF_WI);
  bf16_t* Yb = (bf16_t*)(ws + OFF_YA);
  char* wl_ = smem + w * WAVE_LDS;
  int* sidxA = (int*)wl_;
  int* sidxB = (int*)(wl_ + 16384);
  float* spl = (float*)(wl_ + 1024);
  bf16_t* pbf = (bf16_t*)(wl_ + 6144);
  char* vimg = wl_ + 8192;
  const int b = tokenA >> 12, pos = tokenA & 4095, qc = pos >> 6;
  const int nkeys = (qc + 1) * 64, nk64 = qc + 1;
  const int cntsel = nkeys <= 256 ? nkeys : 256;
  if (nkeys <= 256) {
    for (int s = lane; s < 256; s += 64) { const int v = (s < nkeys) ? s : 0; sidxA[s] = v; sidxB[s] = v; }
  } else {
    const int l15 = lane & 15, l4 = lane >> 4;
    const bool second = lane >= 32;
    const bf16x8 af = *(const bf16x8*)(qi + (size_t)(tokenA + (l15 >> 3)) * 256 + (l15 & 7) * 32 + 8 * l4);
    s16x4 wa;
    {
      const f32x4 wq = *(const f32x4*)(wi + (size_t)(tokenA + (l15 >> 3)) * 8 + 4 * (l4 & 1));
      const bool on = (l15 >> 3) == (l4 >> 1);
      u32x2 wp; wp[0] = on ? pack2(wq[0], wq[1]) : 0u; wp[1] = on ? pack2(wq[2], wq[3]) : 0u;
      wa = __builtin_bit_cast(s16x4, wp);
    }
    const char* kibase = (const char*)ki + (size_t)b * SEQ * 64;
    const unsigned kioff = (unsigned)(lane * 16);
    unsigned u[128];
#pragma unroll
    for (int i = 0; i < 128; ++i) u[i] = 0u;
#pragma unroll
    for (int c = 0; c < 16; ++c) {
      if (c * 4 < nk64) {
        bf16x8 kf[16];
#pragma unroll
        for (int t = 0; t < 16; ++t) kf[t] = *(const bf16x8*)(kibase + (size_t)(c * 16 + t) * 1024 + kioff);
#pragma unroll
        for (int rr = 0; rr < 8; ++rr) {
          const float s0 = tile_score(af, kf[2 * rr], wa), s1 = tile_score(af, kf[2 * rr + 1], wa);
          const float sv = (l4 & 1) ? s1 : s0;
          u[c * 8 + rr] = (c * 4 + (rr >> 1) < nk64) ? sortable(sv) : 0u;
        }
        __builtin_amdgcn_sched_barrier(0);
      }
    }
    unsigned thr = 0u;
    bool doneA = false, doneB = false;
    for (int bit = 31; bit >= 0; --bit) {
      const unsigned cand = thr | (1u << bit);
      int ca = 0, cb = 0;
#pragma unroll
      for (int c = 0; c < 16; ++c) {
        if (c * 4 < nk64) count_ge8_pair(u[c * 8], u[c * 8 + 1], u[c * 8 + 2], u[c * 8 + 3], u[c * 8 + 4], u[c * 8 + 5], u[c * 8 + 6], u[c * 8 + 7], cand, ca, cb);
      }
      const bool accA = ca >= 256, accB = cb >= 256;
      thr = (second ? accB : accA) ? cand : thr;
      doneA = doneA || (ca == 256); doneB = doneB || (cb == 256);
      if (doneA && doneB) break;
    }
    int* mylist = second ? sidxB : sidxA;
    const int keylo = 16 * (l4 & 1) + l15;
    int bA = 0, bB = 0;
#pragma unroll
    for (int c = 0; c < 16; ++c) {
      if (c * 4 < nk64) {
#pragma unroll
        for (int i = c * 8; i < c * 8 + 8; ++i) {
          const unsigned long long m = __ballot(u[i] > thr);
          const unsigned mlo = (unsigned)m, mhi = (unsigned)(m >> 32);
          const int plo = __builtin_popcount(mlo), phi = __builtin_popcount(mhi);
          const int pre = __builtin_amdgcn_mbcnt_hi(mhi, __builtin_amdgcn_mbcnt_lo(mlo, 0u)) - (second ? plo : 0);
          if (u[i] > thr) mylist[(second ? bB : bA) + pre] = 32 * i + keylo;
          bA += plo; bB += phi;
        }
      }
    }
    if (bA < 256 || bB < 256) {
      int eA = bA, eB = bB;
#pragma unroll
      for (int c = 0; c < 16; ++c) {
        if (c * 4 < nk64) {
#pragma unroll
          for (int i = c * 8; i < c * 8 + 8; ++i) {
            const unsigned long long m = __ballot(u[i] == thr);
            const unsigned mlo = (unsigned)m, mhi = (unsigned)(m >> 32);
            const int plo = __builtin_popcount(mlo), phi = __builtin_popcount(mhi);
            const int posn = (second ? eB : eA) + __builtin_amdgcn_mbcnt_hi(mhi, __builtin_amdgcn_mbcnt_lo(mlo, 0u)) - (second ? plo : 0);
            if (u[i] == thr && posn < 256) mylist[posn] = 32 * i + keylo;
            eA += plo; eB += phi;
          }
        }
      }
    }
  }
#pragma unroll 1
  for (int qsel = 0; qsel < 2; ++qsel) {
    const int token = tokenA + qsel;
    if (qsel == 1) {
      __builtin_amdgcn_fence(__ATOMIC_ACQ_REL, "wavefront");
      for (int s = lane; s < 256; s += 64) sidxA[s] = sidxB[s];
    }
    const int* sidx = sidxA;
  __builtin_amdgcn_fence(__ATOMIC_ACQ_REL, "wavefront");
  asm volatile("" : "+v"(lane));
  const int l15 = lane & 15, l4 = lane >> 4;
#pragma unroll 1
  for (int g = 0; g < 2; ++g) {
    bf16x8 qf0, qf1;
    {
      const bf16_t* qp = qb + (size_t)token * 512 + (g * 4 + (lane & 3)) * 64 + 8 * l4;
      qf0 = *(const bf16x8*)qp; qf1 = *(const bf16x8*)(qp + 32);
    }
    const char* kbbase = (const char*)kb + ((size_t)b * SEQ * 128 + g * 64) * 2;
    float mx[4] = {-INFINITY, -INFINITY, -INFINITY, -INFINITY};
    {
      const int ksl_ = lane >> 3, dch_ = lane & 7;
      u32x4 kk[32];
#pragma unroll
      for (int j = 0; j < 32; ++j) {
        const int key = sidx[j * 8 + ksl_];
        kk[j] = *(const u32x4*)(kbbase + (unsigned)(key * 256 + dch_ * 16));
      }
#pragma unroll
      for (int c = 0; c < 4; ++c) {
#pragma unroll
        for (int jj = 0; jj < 8; ++jj) {
          const int row = 8 * jj + ksl_;
          *(u32x4*)(vimg + row * 128 + ((dch_ ^ ((row >> 1) & 7)) * 16)) = kk[c * 8 + jj];
        }
        __builtin_amdgcn_fence(__ATOMIC_ACQ_REL, "wavefront");
#pragma unroll
        for (int tt = 0; tt < 4; ++tt) {
          const int t = c * 4 + tt;
          const int row = 16 * tt + l15, sw = (row >> 1) & 7;
          const bf16x8 k0 = *(const bf16x8*)(vimg + row * 128 + ((l4 ^ sw) * 16));
          const bf16x8 k1 = *(const bf16x8*)(vimg + row * 128 + (((4 + l4) ^ sw) * 16));
          f32x4 ac = {0.f, 0.f, 0.f, 0.f};
          ac = MFMA16(qf0, k0, ac);
          ac = MFMA16(qf1, k1, ac);
          const bool ok = (t * 16 + l15) < cntsel;
          f32x4 lgv;
#pragma unroll
          for (int i = 0; i < 4; ++i) { lgv[i] = ok ? ac[i] * 0.125f : -INFINITY; mx[i] = fmaxf(mx[i], lgv[i]); }
          float* dstp = (l4 == (t & 3)) ? (spl + (t * 16 + l15) * 4) : (spl + 1024 + lane * 4);
          *(f32x4*)dstp = lgv;
        }
        __builtin_amdgcn_fence(__ATOMIC_ACQ_REL, "wavefront");
      }
    }
    __builtin_amdgcn_sched_barrier(0);
    const int ksl = lane >> 3, dch = lane & 7;
    const char* vbase = (const char*)vb + ((size_t)b * SEQ * 128 + g * 64) * 2;
    u32x4 vv[32];
#pragma unroll
    for (int j = 0; j < 32; ++j) {
      const int key = sidx[j * 8 + ksl];
      vv[j] = *(const u32x4*)(vbase + (unsigned)(key * 256 + dch * 16));
    }
    __builtin_amdgcn_sched_barrier(0);
#pragma unroll
    for (int i = 0; i < 4; ++i) {
#pragma unroll
      for (int o = 1; o < 16; o <<= 1) mx[i] = fmaxf(mx[i], __shfl_xor(mx[i], o));
    }
    __builtin_amdgcn_fence(__ATOMIC_ACQ_REL, "wavefront");
    float sm[4] = {0.f, 0.f, 0.f, 0.f};
    {
      f32x4 lgq[4];
#pragma unroll
      for (int jj = 0; jj < 4; ++jj) lgq[jj] = *(const f32x4*)(spl + (4 * lane + jj) * 4);
#pragma unroll
      for (int i = 0; i < 4; ++i) {
        float pq[4];
#pragma unroll
        for (int jj = 0; jj < 4; ++jj) { pq[jj] = __expf(lgq[jj][i] - mx[i]); sm[i] += pq[jj]; }
        u32x2 w2; w2[0] = pack2(pq[0], pq[1]); w2[1] = pack2(pq[2], pq[3]);
        *(u32x2*)(pbf + i * 256 + 4 * lane) = w2;
      }
    }
#pragma unroll
    for (int i = 0; i < 4; ++i) {
#pragma unroll
      for (int o = 1; o < 64; o <<= 1) sm[i] += __shfl_xor(sm[i], o);
    }
    __builtin_amdgcn_fence(__ATOMIC_ACQ_REL, "wavefront");
    f32x4 oacc[4];
#pragma unroll
    for (int d = 0; d < 4; ++d) oacc[d] = (f32x4){0.f, 0.f, 0.f, 0.f};
    typedef __attribute__((address_space(3))) s16x4 lds_s16x4;
    const int tq = l15 >> 2, tp = l15 & 3;
#pragma unroll
    for (int c = 0; c < 4; ++c) {
#pragma unroll
      for (int jj = 0; jj < 8; ++jj) {
        const int row = 8 * jj + ksl, sw = ((row >> 1) & 1) | (((row >> 3) & 1) << 1);
        *(u32x4*)(vimg + row * 128 + ((dch ^ (sw << 1)) * 16)) = vv[c * 8 + jj];
      }
      __builtin_amdgcn_fence(__ATOMIC_ACQ_REL, "wavefront");
#pragma unroll
      for (int ks = 0; ks < 2; ++ks) {
        const bf16x8 pb = *(const bf16x8*)(pbf + (l15 & 3) * 256 + c * 64 + ks * 32 + 8 * l4);
#pragma unroll
        for (int d = 0; d < 4; ++d) {
          const int vrow_ = ks * 32 + 8 * l4 + tq, vsw_ = ((vrow_ >> 1) & 1) | (((vrow_ >> 3) & 1) << 1);
          const char* ap = vimg + vrow_ * 128 + (((d * 4 + tp) ^ (vsw_ << 2)) * 8);
          const s16x4 lo = __builtin_amdgcn_ds_read_tr16_b64_v4i16((lds_s16x4*)ap);
          const s16x4 hi = __builtin_amdgcn_ds_read_tr16_b64_v4i16((lds_s16x4*)(ap + 512));
          const bf16x8 va8 = __builtin_shufflevector(lo, hi, 0, 1, 2, 3, 4, 5, 6, 7);
          oacc[d] = MFMA16(va8, pb, oacc[d]);
        }
      }
      __builtin_amdgcn_fence(__ATOMIC_ACQ_REL, "wavefront");
    }
    {
      const int hd_ = l15 & 3;
      const float ssel = hd_ == 0 ? sm[0] : (hd_ == 1 ? sm[1] : (hd_ == 2 ? sm[2] : sm[3]));
      const float inv = 1.0f / ssel;
      if (l15 < 4) {
#pragma unroll
        for (int d = 0; d < 4; ++d) {
          u32x2 o; o[0] = pack2(oacc[d][0] * inv, oacc[d][1] * inv); o[1] = pack2(oacc[d][2] * inv, oacc[d][3] * inv);
          *(u32x2*)(Yb + (size_t)token * 1024 + (g * 4 + hd_) * 64 + d * 16 + 4 * l4) = o;
        }
      }
    }
    __builtin_amdgcn_fence(__ATOMIC_ACQ_REL, "wavefront");
  }

  }
}

DI void phase_mixers(const Params& p, char* smem) {
  const int tid = otid(), lane = tid & 63, w = __builtin_amdgcn_readfirstlane(tid >> 6);
  const int nwv = gridDim.x * NWAVE;
  const int wv = blockIdx.x * NWAVE + w;
  int itA = wv, jp = wv;
#pragma unroll 1
  for (int k = 0; itA < 64 * (SEQ / 32) || jp < T_TOK / 2; ++k) {
    if (itA < 64 * (SEQ / 32) && ((k & 1) == 0 || jp >= T_TOK / 2)) { mixA_wave(p, itA, lane); itA += nwv; }
    if (jp < T_TOK / 2) {
      const int bat = jp / (SEQ / 2), pidx = jp & (SEQ / 2 - 1);
      const int ppos = (bat & 1) ? (SEQ / 2 - 1 - pidx) : pidx;
      mixB_pair(p, bat * SEQ + 2 * ppos, smem, lane, w);
      jp += nwv;
    }
  }
  __syncthreads();
}

__global__ void __launch_bounds__(512) fwd_megakernel(Params p) {
  cg::grid_group grid = cg::this_grid();
  __shared__ __attribute__((aligned(1024))) char smem[LDS_BYTES];
  if (p.out == nullptr) grid.sync();
  __shared__ uint4 xb_words;
  if (otid() == 0) xb_words = make_uint4(0u, 0u, 0u, 0u);
  __syncthreads();
  const XcdBarrier xb = xcd_barrier_post((unsigned*)(p.ws + OFF_BAR), (volatile LAS unsigned*)&xb_words);
  phase_prep(p, smem);
  phase_rmsnorm<false, false>(p.x, p.g_mix, (bf16_t*)(p.ws + OFF_HBUF), nullptr);
  xcd_barrier(xb);
  bf16_t* xs = (bf16_t*)p.out;
#pragma unroll 1
  for (int layer = 0; layer < 2; ++layer) {
    char* wl = p.ws + (size_t)layer * WT_LAYER;
    bf16_t* hbuf = (bf16_t*)(p.ws + OFF_HBUF);
    if (layer > 0) {
      phase_rmsnorm<true, false>(xs, p.g_mix + DM, hbuf, nullptr);
      xcd_barrier(xb);
    }
    { EpiInproj E; E.ws = p.ws; run_gemm(smem, hbuf, (const bf16_t*)(wl + WT_IN), NPAD_IN, 1024, E); }
    xcd_barrier(xb);
    phase_mixers(p, smem);
    xcd_barrier(xb);
    { EpiMergeFused E; E.gates = (const bf16_t*)(p.ws + OFF_GATES); E.O = hbuf;
      run_gemm(smem, (const bf16_t*)(p.ws + OFF_YA), (const bf16_t*)(wl + WT_UPA), 1024, 1024, E); }
    xcd_barrier(xb);
    if (layer == 0) { EpiResid<true> E; E.R = p.x; E.O = xs; run_gemm(smem, hbuf, (const bf16_t*)(wl + WT_O), 1024, 1024, E); }
    else            { EpiResid<false> E; E.R = xs; E.O = xs; run_gemm(smem, hbuf, (const bf16_t*)(wl + WT_O), 1024, 1024, E); }
    xcd_barrier(xb);
    phase_rmsnorm<true, false>(xs, p.g_mlp + layer * DM, hbuf, nullptr);
    xcd_barrier(xb);
    { EpiSqrelu E; E.O = (bf16_t*)(p.ws + OFF_HIDDEN); run_gemm(smem, hbuf, (const bf16_t*)(wl + WT_FF1), 4096, 1024, E); }
    xcd_barrier(xb);
    { EpiResid<false> E; E.R = xs; E.O = layer == 0 ? xs : hbuf; run_gemm(smem, (const bf16_t*)(p.ws + OFF_HIDDEN), (const bf16_t*)(wl + WT_FF2), 1024, 4096, E); }
    xcd_barrier(xb);
  }
  phase_rmsnorm<true, true>((const bf16_t*)(p.ws + OFF_HBUF), p.g_final, nullptr, p.out);
}

extern "C" void kernel_launch(void* const* d_in, const int* in_sizes, int n_in,
                              void* d_out, int out_size, void* d_ws, size_t ws_size,
                              hipStream_t stream) {
  static int grid_blocks = 0;
  if (!grid_blocks) {
    int dev = 0, cus = 0, per_cu = 0;
    (void)hipGetDevice(&dev);
    (void)hipDeviceGetAttribute(&cus, hipDeviceAttributeMultiprocessorCount, dev);
    (void)hipOccupancyMaxActiveBlocksPerMultiprocessor(&per_cu, fwd_megakernel, NTHR, 0);
    if (per_cu > 1) per_cu = 1;
    if (per_cu < 1) per_cu = 1;
    grid_blocks = cus * per_cu;
  }
  Params p{};
  p.x = (const float*)d_in[0]; p.g_mix = (const float*)d_in[1]; p.w_in = (const float*)d_in[2];
  p.w_up_a = (const float*)d_in[3]; p.w_up_b = (const float*)d_in[4]; p.w_o = (const float*)d_in[5];
  p.g_mlp = (const float*)d_in[6]; p.w_ff1 = (const float*)d_in[7]; p.w_ff2 = (const float*)d_in[8];
  p.g_final = (const float*)d_in[9];
  p.out = (float*)d_out; p.ws = (char*)d_ws;
  (void)hipMemsetAsync((char*)d_ws + OFF_BAR, 0, XCD_BAR_WORDS * 4, stream);
  void* args[] = {&p};
  hipError_t e = hipLaunchCooperativeKernel((void*)fwd_megakernel, dim3(grid_blocks), dim3(NTHR), args, 0, stream);
  if (e != hipSuccess) fprintf(stderr, "cooperative launch failed: %s (grid %d)\n", hipGetErrorString(e), grid_blocks);
}
```

```cpp
#include <hip/hip_runtime.h>
#include <hip/hip_bf16.h>
#include <hip/hip_cooperative_groups.h>
#include <cstdio>
namespace cg = cooperative_groups;

#define DI __device__ __forceinline__
typedef __bf16 bf2_t __attribute__((ext_vector_type(2)));
typedef float fl2_t __attribute__((ext_vector_type(2)));
DI int otid() { int t = threadIdx.x; asm volatile("" : "+v"(t)); return t; }

#define XB_TMO      128
#define XB_XCNT(j)  (256  + 64 * (j))
#define XB_XSUB(j)  (1280 + 64 * (j))
#define XB_XGEN(j)  (2304 + 64 * (j))
#define XB_TOP      3328
#define XB_TOPGEN   3392
#define XCD_BAR_WORDS 3456
#define XB_SPIN_CAP (1u << 18)
#define LAS __attribute__((address_space(3)))

__device__ __forceinline__ unsigned xb_ld(unsigned* p)              { return __hip_atomic_load(p, __ATOMIC_RELAXED, __HIP_MEMORY_SCOPE_AGENT); }
__device__ __forceinline__ unsigned xb_add(unsigned* p, unsigned v) { return __hip_atomic_fetch_add(p, v, __ATOMIC_RELAXED, __HIP_MEMORY_SCOPE_AGENT); }
__device__ __forceinline__ unsigned xb_xcc_id() { return (unsigned)__builtin_amdgcn_s_getreg((3 << 11) | 20) & 0xFu; }
#define XB_SPIN(cond, bar) do { unsigned _sp = 0; while (cond) { __builtin_amdgcn_s_sleep(1); \
    if ((++_sp & 255u) == 0u) { if (xb_ld(&(bar)[XB_TMO])) break; if (_sp > XB_SPIN_CAP) { atomicAdd(&(bar)[XB_TMO], 1u); break; } } } } while (0)

struct XcdBarrier {
    unsigned* bar; unsigned x;
    volatile LAS unsigned* st;
};

__device__ __forceinline__ XcdBarrier xcd_barrier_post(unsigned* bar, volatile LAS unsigned* st) {
    XcdBarrier b; b.bar = bar; b.x = xb_xcc_id(); b.st = st;
    if (otid() == 0) (void)xb_add(&bar[XB_XCNT(b.x)], 1u);
    return b;
}
__device__ __forceinline__ void xcd_barrier_complete(unsigned* bar, unsigned x, unsigned& nloc, unsigned& nx) {
    const unsigned G = gridDim.x * gridDim.y * gridDim.z;
    unsigned sum, cnt, mine, sp = 0u;
    for (;;) {
        sum = 0u; cnt = 0u; mine = 0u;
#pragma unroll
        for (unsigned j = 0; j < 16; ++j) { const unsigned c = xb_ld(&bar[XB_XCNT(j)]); sum += c; cnt += (c > 0u) ? 1u : 0u; mine = (j == x) ? c : mine; }
        if (sum == G) break;
        __builtin_amdgcn_s_sleep(1);
        if ((++sp & 255u) == 0u) { if (xb_ld(&bar[XB_TMO])) break; if (sp > XB_SPIN_CAP) { atomicAdd(&bar[XB_TMO], 1u); break; } }
    }
    nloc = mine > 0u ? mine : 1u; nx = cnt > 0u ? cnt : 1u;
}

__device__ __forceinline__ void xcd_barrier(const XcdBarrier& b) {
    asm volatile("s_waitcnt vmcnt(0)" ::: "memory");
    __syncthreads();
    if (otid() == 0) {
        unsigned* bar = b.bar; unsigned bx_ = b.x;
        asm volatile("" : "+s"(bar), "+s"(bx_));
        __builtin_amdgcn_s_waitcnt(0);
        unsigned nloc = b.st[0], nx = b.st[1];
        if (nloc == 0u) { xcd_barrier_complete(bar, bx_, nloc, nx); b.st[0] = nloc; b.st[1] = nx; }
        const unsigned old = xb_add(&bar[XB_XSUB(bx_)], 1u);
        const unsigned gen = old / nloc;
        if (old + 1u == (gen + 1u) * nloc) {
            __builtin_amdgcn_fence(__ATOMIC_RELEASE, "agent");
            asm volatile("s_waitcnt vmcnt(0)" ::: "memory");
            const unsigned og = xb_add(&bar[XB_TOP], 1u);
            const unsigned tg = og / nx;
            if (og + 1u == (tg + 1u) * nx) xb_add(&bar[XB_TOPGEN], 1u);
            else XB_SPIN(xb_ld(&bar[XB_TOPGEN]) == tg, bar);
            __builtin_amdgcn_fence(__ATOMIC_ACQUIRE, "agent");
            xb_add(&bar[XB_XGEN(bx_)], 1u);
            asm volatile("s_waitcnt vmcnt(0)" ::: "memory");
        } else {
            XB_SPIN(xb_ld(&bar[XB_XGEN(bx_)]) == gen, bar);
            __builtin_amdgcn_fence(__ATOMIC_ACQUIRE, "agent");
            asm volatile("s_waitcnt vmcnt(0)" ::: "memory");
        }
    }
    __syncthreads();
}

namespace pg8 {
#define PG8_LAS __attribute__((address_space(3)))
typedef unsigned short bf16_t;
typedef short bf16x8 __attribute__((ext_vector_type(8)));
typedef float f32x4 __attribute__((ext_vector_type(4)));
typedef unsigned u32x4 __attribute__((ext_vector_type(4)));
constexpr int BM = 256, BK = 64, HALF = 128, HTB = HALF * BK * 2  , STAGE_BYTES = 8 * HTB, NXCD = 8, WGM = 4;

__host__ __device__ __forceinline__ int lds_byte(int r, int c) { const int st = (r >> 4) * 2 + (c >> 5), rr = r & 15, cc = c & 31, ob = rr * 64 + cc * 2; return st * 1024 + (ob ^ (((ob >> 9) & 1) << 5)); }
__host__ __device__ __forceinline__ void stage_rc(int b, int& R, int& C) { const int st = b / 1024, sb = b % 1024, swz = sb ^ (((sb >> 9) & 1) << 5); R = (st >> 1) * 16 + swz / 64; C = (st & 1) * 32 + (swz % 64) / 2; }
__host__ __device__ __forceinline__ int perm32(int rho) { const int n = rho >> 4, i = rho & 15; return 8 * (i >> 2) + 4 * n + (i & 3); }

struct Unit { int pm, pn; };
struct Gemm { const bf16_t* A; const bf16_t* Bt; int M, N, K; };
struct StaticOrder {
    int nM, nN, nwg, G, c;
    __host__ __device__ void init(int M, int N, int G_, int c_) { nM = M / BM; nN = N / BM; nwg = nM * nN; G = G_; c = c_; }
    __host__ __device__ bool next(int i, Unit& u) const {
        const long L = (long)i * G + c; if (L >= nwg) return false;
        int wgid = (int)L; { const int q = nwg / NXCD, r = nwg % NXCD, xcd = wgid % NXCD, off = wgid / NXCD; wgid = (xcd < r ? xcd * (q + 1) : r * (q + 1) + (xcd - r) * q) + off; }
        const int nig = WGM * nN, gid = wgid / nig, fm = gid * WGM, gsz = (nM - fm) < WGM ? (nM - fm) : WGM;
        u.pm = fm + ((wgid % nig) % gsz); u.pn = (wgid % nig) / gsz; return true;
    }
    __device__ __forceinline__ void a_ready(const Unit&) const {}
    __device__ __forceinline__ void done(const Unit&) const {}
};
template <class Epi, class Sched, bool STAMP = false>
__device__ __forceinline__ void gemm_phase(PG8_LAS unsigned char* lds, const Gemm g, const Sched& S, const Epi& E, unsigned long long* stamps) {
    const int tid = otid(), wid = __builtin_amdgcn_readfirstlane(tid >> 6), lane = tid & 63, wr = wid >> 2, wc = wid & 3, fr = lane & 15, fq = lane >> 4;
    const int K = g.K, nt = K / BK;
    int ts_lo = 0, ts_hi = 0, nts = 0; const unsigned long long rt_entry = STAMP ? (unsigned long long)wall_clock64() : 0ull;
#define PG8_STAMP() do { if (STAMP && wid == 0 && nts < 64) { const unsigned long long _c = (unsigned long long)clock64(); \
        ts_lo = (lane == nts) ? (int)(unsigned)_c : ts_lo; ts_hi = (lane == nts) ? (int)(unsigned)(_c >> 32) : ts_hi; ++nts; } } while (0)
    PG8_STAMP();
    unsigned voffA[2], voffB[2];
#pragma unroll
    for (int i = 0; i < 2; ++i) { int R, C; stage_rc(tid * 16 + i * 8192, R, C); const int Rb = Epi::PERM ? ((R & ~31) + perm32(R & 31)) : R;
        voffA[i] = (unsigned)(R * K + C) * 2u; voffB[i] = (unsigned)(Rb * K + C) * 2u; }
    const size_t kstep = (size_t)(BK * 2);
    const size_t hstep = (size_t)HALF * K * 2;
    const size_t tstep = 2 * hstep;
    const unsigned ldsw = (unsigned)wid * 1024u;
    const int aoff = lds_byte(wr * 64 + fr, fq * 8), boff = lds_byte(wc * 32 + fr, fq * 8);
#define PG8_SA(b, h) (((b) * 2 + (h)) * HTB)
#define PG8_SB(b, h) ((4 + (b) * 2 + (h)) * HTB)
#define PG8_STAGE(bufoff, gbase, voff) do { _Pragma("unroll") for (int _i = 0; _i < 2; ++_i) \
        __builtin_amdgcn_global_load_lds((const unsigned*)((const char*)(gbase) + (voff)[_i]), (PG8_LAS unsigned*)(lds + (bufoff) + ldsw + _i * 8192), 16, 0, 0); } while (0)
#define PG8_LDA(dst, b, h) do { _Pragma("unroll") for (int m = 0; m < 4; ++m) _Pragma("unroll") for (int k = 0; k < 2; ++k) dst[m][k] = *(const PG8_LAS bf16x8*)(lds + PG8_SA(b, h) + aoff + m * 2048 + k * 1024); } while (0)
#define PG8_LDB(dst, b, h) do { _Pragma("unroll") for (int n = 0; n < 2; ++n) _Pragma("unroll") for (int k = 0; k < 2; ++k) dst[n][k] = *(const PG8_LAS bf16x8*)(lds + PG8_SB(b, h) + boff + n * 2048 + k * 1024); } while (0)
#define PG8_MMA(ai, bj, At, Bt) do { __builtin_amdgcn_s_setprio(1); _Pragma("unroll") for (int m = 0; m < 4; ++m) _Pragma("unroll") for (int n = 0; n < 2; ++n) _Pragma("unroll") for (int k = 0; k < 2; ++k) \
        acc[ai][bj][m][n] = __builtin_amdgcn_mfma_f32_16x16x32_bf16(Bt[n][k], At[m][k], acc[ai][bj][m][n], 0, 0, 0); __builtin_amdgcn_s_setprio(0); } while (0)
#define PG8_WAIT_V(n) asm volatile("s_waitcnt vmcnt(" #n ")" ::: "memory")
#define PG8_WAIT_L(n) asm volatile("s_waitcnt lgkmcnt(" #n ")" ::: "memory")
#define PG8_BAR __builtin_amdgcn_s_barrier()
#define PG8_SCHED __builtin_amdgcn_sched_barrier(0)
    Unit cur, nxt; int ui = 0;
    if (!S.next(0, cur)) return;
    f32x4 acc[2][2][4][2];
#pragma unroll
    for (int a = 0; a < 2; ++a)
#pragma unroll
        for (int b = 0; b < 2; ++b)
#pragma unroll
            for (int m = 0; m < 4; ++m)
#pragma unroll
                for (int n = 0; n < 2; ++n) acc[a][b][m][n] = (f32x4){0.f, 0.f, 0.f, 0.f};
    bf16x8 At[4][2], B0[2][2], B1[2][2];
    const char* cA = (const char*)g.A + (size_t)cur.pm * tstep; const char* cB = (const char*)g.Bt + (size_t)cur.pn * tstep;
    S.a_ready(cur);
    PG8_STAGE(PG8_SB(0, 0), cB, voffB); PG8_STAGE(PG8_SA(0, 0), cA, voffA); PG8_STAGE(PG8_SB(0, 1), cB + hstep, voffB); PG8_STAGE(PG8_SA(0, 1), cA + hstep, voffA);
    if (wr == 1) PG8_BAR;
    PG8_WAIT_V(4); PG8_BAR;
    PG8_STAGE(PG8_SB(1, 0), cB + kstep, voffB); PG8_STAGE(PG8_SA(1, 0), cA + kstep, voffA); PG8_STAGE(PG8_SB(1, 1), cB + hstep + kstep, voffB);
    PG8_WAIT_V(6); PG8_BAR;
    PG8_STAMP();
    for (;;) {
        const bool has_next = S.next(ui + 1, nxt);
        const char* nA = has_next ? (const char*)g.A + (size_t)nxt.pm * tstep : cA; const char* nB = has_next ? (const char*)g.Bt + (size_t)nxt.pn * tstep : cB;
        for (int t = 0; t < nt; t += 2) {
            if constexpr (Epi::MIDK) { if (t == nt / 2) E.mid(acc, cur, wr, wc, fr, fq); }
            const bool last = (t == nt - 2);
            const char* a1 = cA + (size_t)(t + 1) * kstep;
            const char* a2 = last ? nA : cA + (size_t)(t + 2) * kstep; const char* b2 = last ? nB : cB + (size_t)(t + 2) * kstep;
            const char* a3 = a2 + kstep; const char* b3 = b2 + kstep;
            if (last && has_next) S.a_ready(nxt);
            PG8_LDB(B0, 0, 0); PG8_SCHED; PG8_LDA(At, 0, 0); PG8_STAGE(PG8_SA(1, 1), a1 + hstep, voffA);
            PG8_WAIT_L(8); PG8_BAR; PG8_WAIT_L(0); PG8_MMA(0, 0, At, B0); PG8_BAR; PG8_SCHED;
            PG8_LDB(B1, 0, 1); PG8_STAGE(PG8_SB(0, 0), b2, voffB);
            PG8_BAR; PG8_WAIT_L(0); PG8_MMA(0, 1, At, B1); PG8_BAR;
            PG8_LDA(At, 0, 1); PG8_STAGE(PG8_SA(0, 0), a2, voffA);
            PG8_BAR; PG8_WAIT_L(0); PG8_MMA(1, 0, At, B0); PG8_BAR; PG8_SCHED;
            PG8_STAGE(PG8_SB(0, 1), b2 + hstep, voffB);
            PG8_WAIT_V(6); PG8_BAR; PG8_MMA(1, 1, At, B1); PG8_BAR;
            PG8_LDB(B0, 1, 0); PG8_SCHED; PG8_LDA(At, 1, 0); PG8_STAGE(PG8_SA(0, 1), a2 + hstep, voffA);
            PG8_WAIT_L(8); PG8_BAR; PG8_WAIT_L(0); PG8_MMA(0, 0, At, B0); PG8_BAR; PG8_SCHED;
            PG8_LDB(B1, 1, 1); PG8_STAGE(PG8_SB(1, 0), b3, voffB);
            PG8_BAR; PG8_WAIT_L(0); PG8_MMA(0, 1, At, B1); PG8_BAR;
            PG8_LDA(At, 1, 1); PG8_STAGE(PG8_SA(1, 0), a3, voffA);
            PG8_BAR; PG8_WAIT_L(0); PG8_MMA(1, 0, At, B0); PG8_BAR; PG8_SCHED;
            PG8_STAGE(PG8_SB(1, 1), b3 + hstep, voffB);
            PG8_WAIT_V(6); PG8_BAR; PG8_MMA(1, 1, At, B1); PG8_BAR;
        }
        PG8_STAMP();
        if constexpr (!Epi::AFTER_DRAIN) { E(acc, cur, wr, wc, fr, fq); S.done(cur); }
        PG8_STAMP();
        if (!has_next) break;
#pragma unroll
        for (int a = 0; a < 2; ++a)
#pragma unroll
            for (int b = 0; b < 2; ++b)
#pragma unroll
                for (int m = 0; m < 4; ++m)
#pragma unroll
                    for (int n = 0; n < 2; ++n) acc[a][b][m][n] = (f32x4){0.f, 0.f, 0.f, 0.f};
        cur = nxt; cA = nA; cB = nB; ++ui;
    }
    PG8_WAIT_V(0);
    if (wr == 0) PG8_BAR;
    PG8_BAR;
    if constexpr (Epi::AFTER_DRAIN) { E.fused(acc, cur, wr, wc, fr, fq, lds, wid, lane); S.done(cur); }
    PG8_STAMP();
    if (STAMP && wid == 0) { stamps[lane] = lane < nts ? (((unsigned long long)(unsigned)ts_hi << 32) | (unsigned)ts_lo) : 0ull;
        if (lane == 62) stamps[62] = rt_entry; if (lane == 63) stamps[63] = (unsigned long long)wall_clock64(); }
#undef PG8_STAMP
#undef PG8_SA
#undef PG8_SB
#undef PG8_STAGE
#undef PG8_LDA
#undef PG8_LDB
#undef PG8_MMA
#undef PG8_WAIT_V
#undef PG8_WAIT_L
#undef PG8_BAR
#undef PG8_SCHED
}
}

typedef unsigned short bf16_t;
using bf16x8 = __attribute__((ext_vector_type(8))) short;
using s16x4  = __attribute__((ext_vector_type(4))) short;
using f32x16 = __attribute__((ext_vector_type(16))) float;
using f32x4  = __attribute__((ext_vector_type(4))) float;
using u32x4  = __attribute__((ext_vector_type(4))) unsigned;
using u32x2  = __attribute__((ext_vector_type(2))) unsigned;

#define MFMA32(a, b, c) __builtin_amdgcn_mfma_f32_32x32x16_bf16((a), (b), (c), 0, 0, 0)
#define MFMA16(a, b, c) __builtin_amdgcn_mfma_f32_16x16x32_bf16((a), (b), (c), 0, 0, 0)

constexpr int NTHR = 512, NWAVE = 8;
constexpr int T_TOK = 32768, SEQ = 4096, DM = 1024;
constexpr int NPAD_IN = 4864;
constexpr int SROW = 144;
constexpr int WAVE_LDS = 17408;
constexpr int LDS_BYTES = 8 * WAVE_LDS;

constexpr size_t WT_IN = 0;
constexpr size_t WT_UPA = WT_IN + (size_t)NPAD_IN * 1024 * 2;
constexpr size_t WT_UPB = WT_UPA + (size_t)1024 * 512 * 2;
constexpr size_t WT_O   = WT_UPB + (size_t)1024 * 512 * 2;
constexpr size_t WT_FF1 = WT_O + (size_t)1024 * 1024 * 2;
constexpr size_t WT_FF2 = WT_FF1 + (size_t)4096 * 1024 * 2;
constexpr size_t WT_LAYER = WT_FF2 + (size_t)1024 * 4096 * 2;
constexpr size_t OFF_ROPE = 2 * WT_LAYER;
constexpr size_t OFF_QA = OFF_ROPE + (size_t)SEQ * 24 * 4;
constexpr size_t OFF_KA = OFF_QA + (size_t)T_TOK * 512 * 2;
constexpr size_t OFF_VAT = OFF_KA + (size_t)T_TOK * 512 * 2;
constexpr size_t OFF_QB = OFF_VAT + (size_t)T_TOK * 512 * 2;
constexpr size_t OFF_KB = OFF_QB + (size_t)T_TOK * 512 * 2;
constexpr size_t OFF_VB = OFF_KB + (size_t)T_TOK * 128 * 2;
constexpr size_t OFF_QI = OFF_VB + (size_t)T_TOK * 128 * 2;
constexpr size_t OFF_KI = OFF_QI + (size_t)T_TOK * 256 * 2;
constexpr size_t OFF_WI = OFF_KI + (size_t)T_TOK * 32 * 2;
constexpr size_t OFF_GATES = OFF_WI + (size_t)T_TOK * 8 * 4;
constexpr size_t OFF_PROJ_END = OFF_GATES + (size_t)T_TOK * 2048 * 2;
constexpr size_t OFF_HIDDEN = OFF_QA;
constexpr size_t OFF_YA = OFF_PROJ_END;
constexpr size_t OFF_YB = OFF_YA + (size_t)T_TOK * 512 * 2;
constexpr size_t OFF_HBUF = OFF_YB + (size_t)T_TOK * 512 * 2;
constexpr size_t OFF_END = OFF_HBUF + (size_t)T_TOK * 1024 * 2;
constexpr size_t OFF_BAR = OFF_END;
static_assert(OFF_BAR + XCD_BAR_WORDS * 4 <= (size_t)512 * 1024 * 1024, "workspace too large");
static_assert(OFF_HIDDEN + (size_t)T_TOK * 4096 * 2 <= OFF_PROJ_END, "hidden alias");

struct Params {
  const float* x; const float* g_mix; const float* w_in; const float* w_up_a; const float* w_up_b;
  const float* w_o; const float* g_mlp; const float* w_ff1; const float* w_ff2; const float* g_final;
  float* out; char* ws;
};

DI unsigned pack2(float a, float b) {
  fl2_t f = {a, b};
  bf2_t r = __builtin_convertvector(f, bf2_t);
  return __builtin_bit_cast(unsigned, r);
}
DI bf16_t f2bf(float a) { return (bf16_t)(pack2(a, 0.f) & 0xffffu); }
DI float bflo(unsigned w) { return __uint_as_float(w << 16); }
DI float bfhi(unsigned w) { return __uint_as_float(w & 0xffff0000u); }
DI int crow(int reg, int h) { return (reg & 3) + 8 * (reg >> 2) + 4 * h; }
DI u32x4 pack8(const f32x4& a, const f32x4& b) {
  u32x4 w; w[0] = pack2(a[0], a[1]); w[1] = pack2(a[2], a[3]); w[2] = pack2(b[0], b[1]); w[3] = pack2(b[2], b[3]); return w;
}

DI int src_col(int nd, int mode) {
  if (!mode) return nd;
  if (nd < 2560) return nd;
  if (nd < 4608) { const int blk = (nd - 2560) >> 7; return 2600 + (blk & 1) * 1024 + (blk >> 1) * 128 + (nd & 127); }
  if (nd < 4648) return nd - 2048;
  return -1;
}
DI void convT(const float* __restrict__ W, int K, int N, bf16_t* __restrict__ WT, int NR, int mode, char* smem, int ldw = 0, int koff = 0) {
  if (ldw == 0) ldw = K;
  float* tile = (float*)smem;
  const int tid = otid();
  const int kt_n = K / 64, nt_n = NR / 64;
  for (int t = blockIdx.x; t < kt_n * nt_n; t += gridDim.x) {
    const int k0 = (t % kt_n) * 64, n0 = (t / kt_n) * 64;
    const int nl = tid & 63;
    const int sc = src_col(n0 + nl, mode);
    __syncthreads();
#pragma unroll
    for (int r = 0; r < 8; ++r) {
      const int kl = r * 8 + (tid >> 6);
      float v = 0.f;
      if (sc >= 0) v = W[(size_t)(k0 + kl) * N + sc];
      tile[kl * 65 + nl] = v;
    }
    __syncthreads();
    const int nrow = tid >> 3, ks = (tid & 7) * 8;
    u32x4 o0;
#pragma unroll
    for (int j = 0; j < 4; ++j) o0[j] = pack2(tile[(ks + 2 * j) * 65 + nrow], tile[(ks + 2 * j + 1) * 65 + nrow]);
    *(u32x4*)(WT + (size_t)(n0 + nrow) * ldw + koff + k0 + ks) = o0;
  }
}

DI void phase_prep(const Params& p, char* smem) {
  for (int l = 0; l < 2; ++l) {
    char* wl = p.ws + (size_t)l * WT_LAYER;
    convT(p.w_in + (size_t)l * 1024 * 4648, 1024, 4648, (bf16_t*)(wl + WT_IN), NPAD_IN, 1, smem);
    convT(p.w_up_b + (size_t)l * 512 * 1024, 512, 1024, (bf16_t*)(wl + WT_UPA), 1024, 0, smem, 1024, 0);
    convT(p.w_up_a + (size_t)l * 512 * 1024, 512, 1024, (bf16_t*)(wl + WT_UPA), 1024, 0, smem, 1024, 512);
    convT(p.w_o + (size_t)l * 1024 * 1024, 1024, 1024, (bf16_t*)(wl + WT_O), 1024, 0, smem);
    convT(p.w_ff1 + (size_t)l * 1024 * 4096, 1024, 4096, (bf16_t*)(wl + WT_FF1), 4096, 0, smem);
    convT(p.w_ff2 + (size_t)l * 4096 * 1024, 4096, 1024, (bf16_t*)(wl + WT_FF2), 1024, 0, smem);
  }
  float* rope = (float*)(p.ws + OFF_ROPE);
  for (int i = blockIdx.x * NTHR + otid(); i < SEQ * 12; i += gridDim.x * NTHR) {
    const int pos = i / 12, f = i % 12;
    float inv; int co, so;
    if (f < 8) { inv = powf(500000.0f, -((float)(2 * f) / 16.0f)); co = f; so = 8 + f; }
    else { inv = powf(500000.0f, -((float)(2 * (f - 8)) / 8.0f)); co = 16 + (f - 8); so = 20 + (f - 8); }
    const float ang = (float)pos * inv;
    float s, c; sincosf(ang, &s, &c);
    rope[pos * 24 + co] = c; rope[pos * 24 + so] = s;
  }
}

template <bool IN_BF, bool FINAL>
DI void phase_rmsnorm(const void* __restrict__ xin_, const float* __restrict__ g, bf16_t* __restrict__ hout, float* __restrict__ fout) {
  const int tid_ = otid(); const int wave = tid_ >> 6, lane = tid_ & 63;
  for (int t = blockIdx.x * NWAVE + wave; t < T_TOK; t += gridDim.x * NWAVE) {
    float v[16]; float ss = 0.f;
    if (IN_BF) {
      const u32x4* src = (const u32x4*)((const bf16_t*)xin_ + (size_t)t * DM);
#pragma unroll
      for (int i = 0; i < 2; ++i) {
        const u32x4 w4 = src[lane + 64 * i];
#pragma unroll
        for (int j = 0; j < 4; ++j) { v[8 * i + 2 * j] = bflo(w4[j]); v[8 * i + 2 * j + 1] = bfhi(w4[j]); }
      }
    } else {
      const float4* src = (const float4*)((const float*)xin_ + (size_t)t * DM);
#pragma unroll
      for (int i = 0; i < 4; ++i) { const float4 f = src[2 * lane + 128 * (i >> 1) + (i & 1)]; v[4 * i] = f.x; v[4 * i + 1] = f.y; v[4 * i + 2] = f.z; v[4 * i + 3] = f.w; }
    }
#pragma unroll
    for (int k = 0; k < 16; ++k) ss += v[k] * v[k];
#pragma unroll
    for (int o = 32; o > 0; o >>= 1) ss += __shfl_xor(ss, o);
    const float r = rsqrtf(ss * (1.0f / DM) + 1e-6f);
#pragma unroll
    for (int i = 0; i < 2; ++i) {
      const int e0 = (lane + 64 * i) * 8;
      const float4 g0 = *(const float4*)(g + e0), g1 = *(const float4*)(g + e0 + 4);
      float o8[8];
      o8[0] = v[8 * i] * r * g0.x; o8[1] = v[8 * i + 1] * r * g0.y; o8[2] = v[8 * i + 2] * r * g0.z; o8[3] = v[8 * i + 3] * r * g0.w;
      o8[4] = v[8 * i + 4] * r * g1.x; o8[5] = v[8 * i + 5] * r * g1.y; o8[6] = v[8 * i + 6] * r * g1.z; o8[7] = v[8 * i + 7] * r * g1.w;
      if (FINAL) {
        float4 a, b; a.x = o8[0]; a.y = o8[1]; a.z = o8[2]; a.w = o8[3]; b.x = o8[4]; b.y = o8[5]; b.z = o8[6]; b.w = o8[7];
        *(float4*)(fout + (size_t)t * DM + e0) = a; *(float4*)(fout + (size_t)t * DM + e0 + 4) = b;
      } else {
        u32x4 w4; w4[0] = pack2(o8[0], o8[1]); w4[1] = pack2(o8[2], o8[3]); w4[2] = pack2(o8[4], o8[5]); w4[3] = pack2(o8[6], o8[7]);
        *(u32x4*)(hout + (size_t)t * DM + e0) = w4;
      }
    }
  }
}


struct EpiInproj {
  static constexpr bool PERM = true, AFTER_DRAIN = false, MIDK = false;
  char* ws;
  DI void operator()(const f32x4 (&acc)[2][2][4][2], const pg8::Unit& u, int wr, int wc, int fr_in, int fq_in) const {
    int fr = fr_in, fq = fq_in; asm volatile("" : "+v"(fr), "+v"(fq));
    const float* rope = (const float*)(ws + OFF_ROPE);
    bf16_t* qa = (bf16_t*)(ws + OFF_QA); bf16_t* ka = (bf16_t*)(ws + OFF_KA); bf16_t* vaT = (bf16_t*)(ws + OFF_VAT);
    bf16_t* qb = (bf16_t*)(ws + OFF_QB); bf16_t* kb = (bf16_t*)(ws + OFF_KB); bf16_t* vb = (bf16_t*)(ws + OFF_VB);
    bf16_t* qi = (bf16_t*)(ws + OFF_QI); bf16_t* ki = (bf16_t*)(ws + OFF_KI); float* wi = (float*)(ws + OFF_WI);
    bf16_t* gates = (bf16_t*)(ws + OFF_GATES);
    const int cl8 = wc * 32 + 8 * fq;
    if (u.pn >= 10 && u.pn < 18) {
      bf16_t* gA = (bf16_t*)(ws + OFF_GATES); bf16_t* gR = gA + (size_t)T_TOK * 1024;
      const int ch0 = (u.pn - 10) * 128 + cl8;
#pragma unroll
      for (int ai = 0; ai < 2; ++ai)
#pragma unroll
        for (int m = 0; m < 4; ++m) {
          const int tok = u.pm * 256 + ai * 128 + wr * 64 + m * 16 + fr;
          f32x4 a0 = acc[ai][0][m][0], a1 = acc[ai][0][m][1], b0 = acc[ai][1][m][0], b1 = acc[ai][1][m][1];
#pragma unroll
          for (int j = 0; j < 4; ++j) {
            a0[j] = __builtin_amdgcn_rcpf(1.0f + __expf(-a0[j])); a1[j] = __builtin_amdgcn_rcpf(1.0f + __expf(-a1[j]));
            b0[j] = __builtin_amdgcn_rcpf(1.0f + __expf(-b0[j])); b1[j] = __builtin_amdgcn_rcpf(1.0f + __expf(-b1[j]));
          }
          const u32x4 wa4 = pack8(a0, a1);
          *(u32x4*)(gA + (size_t)tok * 1024 + ch0) = wa4;
          f32x4 r0, r1;
          r0[0] = b0[0] * __builtin_amdgcn_rcpf(fmaxf(bflo(wa4[0]), 1e-20f)); r0[1] = b0[1] * __builtin_amdgcn_rcpf(fmaxf(bfhi(wa4[0]), 1e-20f));
          r0[2] = b0[2] * __builtin_amdgcn_rcpf(fmaxf(bflo(wa4[1]), 1e-20f)); r0[3] = b0[3] * __builtin_amdgcn_rcpf(fmaxf(bfhi(wa4[1]), 1e-20f));
          r1[0] = b1[0] * __builtin_amdgcn_rcpf(fmaxf(bflo(wa4[2]), 1e-20f)); r1[1] = b1[1] * __builtin_amdgcn_rcpf(fmaxf(bfhi(wa4[2]), 1e-20f));
          r1[2] = b1[2] * __builtin_amdgcn_rcpf(fmaxf(bflo(wa4[3]), 1e-20f)); r1[3] = b1[3] * __builtin_amdgcn_rcpf(fmaxf(bfhi(wa4[3]), 1e-20f));
          *(u32x4*)(gR + (size_t)tok * 1024 + ch0) = pack8(r0, r1);
        }
      return;
    }
#pragma unroll
    for (int bj = 0; bj < 2; ++bj) {
      const int ni = u.pn * 2 + bj;
      if (ni >= 37) continue;
#pragma unroll
      for (int ai = 0; ai < 2; ++ai)
#pragma unroll
        for (int m = 0; m < 4; ++m) {
          const int tok = u.pm * 256 + ai * 128 + wr * 64 + m * 16 + fr;
          const int pos = tok & 4095;
          f32x4 v0 = acc[ai][bj][m][0], v1 = acc[ai][bj][m][1];
          if (ni < 8) {
            bf16_t* dst = (ni < 4) ? qa : ka;
            *(u32x4*)(dst + (size_t)tok * 512 + (ni & 3) * 128 + cl8) = pack8(v0, v1);
          } else if (ni < 12) {
            const int c = (ni - 8) * 128 + cl8; const int hd = c >> 6, d = c & 63; const int b = tok >> 12;
            bf16_t* dst = vaT + ((size_t)((b * 8 + hd) * 64 + d)) * SEQ + pos;
#pragma unroll
            for (int j = 0; j < 4; ++j) { dst[(size_t)j * SEQ] = f2bf(v0[j]); dst[(size_t)(j + 4) * SEQ] = f2bf(v1[j]); }
          } else if (ni < 17) {
            const int d0 = cl8 & 63;
            f32x4 p0, p1;
#pragma unroll
            for (int j = 0; j < 4; ++j) { p0[j] = __shfl_xor(v0[j], 16); p1[j] = __shfl_xor(v1[j], 16); }
            if (d0 < 16) {
              const f32x4 c0 = *(const f32x4*)(rope + pos * 24), c1 = *(const f32x4*)(rope + pos * 24 + 4);
              const f32x4 s0 = *(const f32x4*)(rope + pos * 24 + 8), s1 = *(const f32x4*)(rope + pos * 24 + 12);
              if (d0 == 0) { v0 = v0 * c0 - p0 * s0; v1 = v1 * c1 - p1 * s1; }
              else         { v0 = v0 * c0 + p0 * s0; v1 = v1 * c1 + p1 * s1; }
            }
            if (ni < 16) *(u32x4*)(qb + (size_t)tok * 512 + (ni - 12) * 128 + cl8) = pack8(v0, v1);
            else         *(u32x4*)(kb + (size_t)tok * 128 + cl8) = pack8(v0, v1);
          } else if (ni == 17) {
            *(u32x4*)(vb + (size_t)tok * 128 + cl8) = pack8(v0, v1);
          } else if (ni < 20 || ni == 36) {
            if ((cl8 & 31) == 0 && (ni < 20 || cl8 == 0)) {
              const f32x4 cs = *(const f32x4*)(rope + pos * 24 + 16), sn = *(const f32x4*)(rope + pos * 24 + 20);
              const f32x4 a = v0 * cs - v1 * sn, b2 = v1 * cs + v0 * sn;
              v0 = a; v1 = b2;
            }
            if (ni < 20) *(u32x4*)(qi + (size_t)tok * 256 + (ni - 18) * 128 + cl8) = pack8(v0, v1);
            else if (cl8 < 32) *(u32x4*)(ki + (size_t)(tok >> 4) * 512 + (cl8 >> 3) * 128 + (tok & 15) * 8) = pack8(v0, v1);
            else if (cl8 == 32) { *(f32x4*)(wi + (size_t)tok * 8) = v0 * 0.0625f; *(f32x4*)(wi + (size_t)tok * 8 + 4) = v1 * 0.0625f; }
          } else {
#pragma unroll
            for (int j = 0; j < 4; ++j) { v0[j] = __builtin_amdgcn_rcpf(1.0f + __expf(-v0[j])); v1[j] = __builtin_amdgcn_rcpf(1.0f + __expf(-v1[j])); }
            *(u32x4*)(gates + (size_t)tok * 2048 + (ni - 20) * 128 + cl8) = pack8(v0, v1);
          }
        }
    }
  }
};

struct EpiSqrelu {
  static constexpr bool PERM = true, AFTER_DRAIN = false, MIDK = false;
  bf16_t* O;
  DI void operator()(const f32x4 (&acc)[2][2][4][2], const pg8::Unit& u, int wr, int wc, int fr_in, int fq_in) const {
    int fr = fr_in, fq = fq_in; asm volatile("" : "+v"(fr), "+v"(fq));
#pragma unroll
    for (int ai = 0; ai < 2; ++ai)
#pragma unroll
      for (int m = 0; m < 4; ++m) {
        bf16_t* rowp = O + (size_t)(u.pm * 256 + ai * 128 + wr * 64 + m * 16 + fr) * 4096 + u.pn * 256 + wc * 32 + 8 * fq;
#pragma unroll
        for (int bj = 0; bj < 2; ++bj) {
          f32x4 v0 = acc[ai][bj][m][0], v1 = acc[ai][bj][m][1];
#pragma unroll
          for (int j = 0; j < 4; ++j) { const float a = fmaxf(v0[j], 0.f), b = fmaxf(v1[j], 0.f); v0[j] = a * a; v1[j] = b * b; }
          __builtin_nontemporal_store(pack8(v0, v1), (u32x4*)(rowp + bj * 128));
        }
      }
  }
};

template <bool RF32>
struct EpiResid {
  static constexpr bool PERM = true, AFTER_DRAIN = false, MIDK = false;
  const void* R; bf16_t* O;
  DI void operator()(const f32x4 (&acc)[2][2][4][2], const pg8::Unit& u, int wr, int wc, int fr_in, int fq_in) const {
    int fr = fr_in, fq = fq_in; asm volatile("" : "+v"(fr), "+v"(fq));
#pragma unroll
    for (int ai = 0; ai < 2; ++ai)
#pragma unroll
      for (int m = 0; m < 4; ++m) {
        const size_t ro = (size_t)(u.pm * 256 + ai * 128 + wr * 64 + m * 16 + fr) * 1024 + u.pn * 256 + wc * 32 + 8 * fq;
#pragma unroll
        for (int bj = 0; bj < 2; ++bj) {
          const size_t o = ro + bj * 128;
          f32x4 v0 = acc[ai][bj][m][0], v1 = acc[ai][bj][m][1];
          if (RF32) { v0 += *(const f32x4*)((const float*)R + o); v1 += *(const f32x4*)((const float*)R + o + 4); }
          else {
            const u32x4 rw = *(const u32x4*)((const bf16_t*)R + o);
            v0[0] += bflo(rw[0]); v0[1] += bfhi(rw[0]); v0[2] += bflo(rw[1]); v0[3] += bfhi(rw[1]);
            v1[0] += bflo(rw[2]); v1[1] += bfhi(rw[2]); v1[2] += bflo(rw[3]); v1[3] += bfhi(rw[3]);
          }
          *(u32x4*)(O + o) = pack8(v0, v1);
        }
      }
  }
};

template <int PASS>
struct EpiMerge {
  static constexpr bool PERM = true, AFTER_DRAIN = false, MIDK = false;
  const bf16_t* gates; bf16_t* O;
  DI void operator()(const f32x4 (&acc)[2][2][4][2], const pg8::Unit& u, int wr, int wc, int fr_in, int fq_in) const {
    int fr = fr_in, fq = fq_in; asm volatile("" : "+v"(fr), "+v"(fq));
#pragma unroll
    for (int ai = 0; ai < 2; ++ai)
#pragma unroll
      for (int m = 0; m < 4; ++m) {
        const int tok = u.pm * 256 + ai * 128 + wr * 64 + m * 16 + fr;
        const int c0 = u.pn * 256 + wc * 32 + 8 * fq;
#pragma unroll
        for (int bj = 0; bj < 2; ++bj) {
          const u32x4 gw = *(const u32x4*)(gates + (size_t)tok * 2048 + (PASS == 1 ? 1024 : 0) + c0 + bj * 128);
          f32x4 v0 = acc[ai][bj][m][0], v1 = acc[ai][bj][m][1];
          v0[0] *= bflo(gw[0]); v0[1] *= bfhi(gw[0]); v0[2] *= bflo(gw[1]); v0[3] *= bfhi(gw[1]);
          v1[0] *= bflo(gw[2]); v1[1] *= bfhi(gw[2]); v1[2] *= bflo(gw[3]); v1[3] *= bfhi(gw[3]);
          bf16_t* op = O + (size_t)tok * 1024 + c0 + bj * 128;
          if (PASS == 2) {
            const u32x4 tw = *(const u32x4*)op;
            v0[0] += bflo(tw[0]); v0[1] += bfhi(tw[0]); v0[2] += bflo(tw[1]); v0[3] += bfhi(tw[1]);
            v1[0] += bflo(tw[2]); v1[1] += bfhi(tw[2]); v1[2] += bflo(tw[3]); v1[3] += bfhi(tw[3]);
          }
          *(u32x4*)op = pack8(v0, v1);
        }
      }
  }
};

struct EpiMergeFused {
  static constexpr bool PERM = true, AFTER_DRAIN = false, MIDK = true;
  const bf16_t* gates; bf16_t* O;
  DI void mid(f32x4 (&acc)[2][2][4][2], const pg8::Unit& u, int wr, int wc, int fr_in, int fq_in) const {
    int fr = fr_in, fq = fq_in; asm volatile("" : "+v"(fr), "+v"(fq));
    const bf16_t* gR = gates + (size_t)T_TOK * 1024;
#pragma unroll
    for (int ai = 0; ai < 2; ++ai)
#pragma unroll
      for (int m = 0; m < 4; ++m) {
        const int tok = u.pm * 256 + ai * 128 + wr * 64 + m * 16 + fr;
        const int c0 = u.pn * 256 + wc * 32 + 8 * fq;
#pragma unroll
        for (int bj = 0; bj < 2; ++bj) {
          const u32x4 rw = *(const u32x4*)(gR + (size_t)tok * 1024 + c0 + bj * 128);
#pragma unroll
          for (int j = 0; j < 4; ++j) { acc[ai][bj][m][j >> 1][(j & 1) * 2] *= bflo(rw[j]); acc[ai][bj][m][j >> 1][(j & 1) * 2 + 1] *= bfhi(rw[j]); }
        }
      }
  }
  DI void operator()(const f32x4 (&acc)[2][2][4][2], const pg8::Unit& u, int wr, int wc, int fr_in, int fq_in) const {
    int fr = fr_in, fq = fq_in; asm volatile("" : "+v"(fr), "+v"(fq));
#pragma unroll
    for (int ai = 0; ai < 2; ++ai)
#pragma unroll
      for (int m = 0; m < 4; ++m) {
        const int tok = u.pm * 256 + ai * 128 + wr * 64 + m * 16 + fr;
        const int c0 = u.pn * 256 + wc * 32 + 8 * fq;
#pragma unroll
        for (int bj = 0; bj < 2; ++bj) {
          const u32x4 ga = *(const u32x4*)(gates + (size_t)tok * 1024 + c0 + bj * 128);
          f32x4 v0 = acc[ai][bj][m][0], v1 = acc[ai][bj][m][1];
          v0[0] *= fmaxf(bflo(ga[0]), 1e-20f); v0[1] *= fmaxf(bfhi(ga[0]), 1e-20f); v0[2] *= fmaxf(bflo(ga[1]), 1e-20f); v0[3] *= fmaxf(bfhi(ga[1]), 1e-20f);
          v1[0] *= fmaxf(bflo(ga[2]), 1e-20f); v1[1] *= fmaxf(bfhi(ga[2]), 1e-20f); v1[2] *= fmaxf(bflo(ga[3]), 1e-20f); v1[3] *= fmaxf(bfhi(ga[3]), 1e-20f);
          *(u32x4*)(O + (size_t)tok * 1024 + c0 + bj * 128) = pack8(v0, v1);
        }
      }
  }
};

template <class Epi>
DI void run_gemm(char* smem, const bf16_t* A, const bf16_t* Bt, int N, int K, const Epi& E) {
  pg8::Gemm g; g.A = A; g.Bt = Bt; g.M = T_TOK; g.N = N; g.K = K;
  int cblk = blockIdx.x; asm volatile("" : "+s"(cblk));
  pg8::StaticOrder S; S.init(T_TOK, N, gridDim.x, cblk);
  pg8::gemm_phase<Epi, pg8::StaticOrder, false>((PG8_LAS unsigned char*)smem, g, S, E, nullptr);
  __syncthreads();
}

DI void mixA_wave(const Params& p, int item, int lane) {
  char* ws = p.ws; asm volatile("" : "+s"(ws));
  const bf16_t* qa = (const bf16_t*)(ws + OFF_QA); const bf16_t* ka = (const bf16_t*)(ws + OFF_KA);
  const bf16_t* vaT = (const bf16_t*)(ws + OFF_VAT); bf16_t* Ya = (bf16_t*)(ws + OFF_YA);
  const int r = lane & 31, h = lane >> 5;
  const int bh = item & 63, qg = item >> 6;
  const int b = bh >> 3, hd = bh & 7;
  const int tq = qg * 32 + r;
  bf16x8 qf[4];
#pragma unroll
  for (int s = 0; s < 4; ++s) qf[s] = *(const bf16x8*)(qa + (size_t)(b * SEQ + tq) * 512 + hd * 64 + 16 * s + 8 * h);
  f32x16 o[2];
#pragma unroll
  for (int e = 0; e < 16; ++e) { o[0][e] = 0.f; o[1][e] = 0.f; }
  float carry = 0.f;
  const bf16_t* kcol = ka + (size_t)(b * SEQ + r) * 512 + hd * 64 + 8 * h;
  const bf16_t* vrow = vaT + ((size_t)((b * 8 + hd) * 64 + r)) * SEQ + 4 * h;
  bf16x8 kf[4];
#pragma unroll
  for (int s = 0; s < 4; ++s) kf[s] = *(const bf16x8*)(kcol + (size_t)(qg * 32) * 512 + 16 * s);
  for (int kt = qg; kt >= 0; --kt) {
    const int kbase = kt * 32;
    s16x4 vlo[2][2], vhi[2][2];
#pragma unroll
    for (int s2 = 0; s2 < 2; ++s2)
#pragma unroll
      for (int db = 0; db < 2; ++db) {
        const bf16_t* vp = vrow + (size_t)(32 * db) * SEQ + kbase + 16 * s2;
        vlo[s2][db] = *(const s16x4*)vp; vhi[s2][db] = *(const s16x4*)(vp + 8);
      }
    bf16x8 kn[4];
    const int knext = (kt > 0 ? kt - 1 : 0) * 32;
#pragma unroll
    for (int s = 0; s < 4; ++s) kn[s] = *(const bf16x8*)(kcol + (size_t)knext * 512 + 16 * s);
    f32x16 sacc;
#pragma unroll
    for (int e = 0; e < 16; ++e) sacc[e] = 0.f;
#pragma unroll
    for (int s = 0; s < 4; ++s) sacc = MFMA32(kf[s], qf[s], sacc);
    float z[16], L[16];
#pragma unroll
    for (int e = 0; e < 16; ++e) {
      z[e] = sacc[e] * 0.125f;
      const bool valid = (kbase + crow(e, h)) < tq;
      const float ex = __expf(-fabsf(z[e]));
      const float sp = fmaxf(z[e], 0.f) + __logf(1.0f + ex);
      L[e] = valid ? -sp : 0.f;
    }
    float G[4], Go[4];
#pragma unroll
    for (int g = 0; g < 4; ++g) { G[g] = (L[4 * g] + L[4 * g + 1]) + (L[4 * g + 2] + L[4 * g + 3]); Go[g] = __shfl_xor(G[g], 32); }
    float higher = 0.f;
    float a[16];
#pragma unroll
    for (int g = 3; g >= 0; --g) {
      const float base = carry + higher + (h == 0 ? Go[g] : 0.f);
      const float c3 = base + L[4 * g + 3];
      const float c2 = c3 + L[4 * g + 2];
      const float c1 = c2 + L[4 * g + 1];
      const float c0 = c1 + L[4 * g];
      const float cc[4] = {c0, c1, c2, c3};
#pragma unroll
      for (int rr = 0; rr < 4; ++rr) {
        const int e = 4 * g + rr;
        const bool valid = (kbase + crow(e, h)) < tq;
        a[e] = valid ? __expf(z[e] + cc[rr]) : 0.f;
      }
      higher += G[g] + Go[g];
    }
    carry += higher;
#pragma unroll
    for (int s2 = 0; s2 < 2; ++s2) {
      u32x4 pk;
#pragma unroll
      for (int j = 0; j < 4; ++j) pk[j] = pack2(a[8 * s2 + 2 * j], a[8 * s2 + 2 * j + 1]);
      const bf16x8 pf = __builtin_bit_cast(bf16x8, pk);
#pragma unroll
      for (int db = 0; db < 2; ++db) {
        const bf16x8 vf = __builtin_shufflevector(vlo[s2][db], vhi[s2][db], 0, 1, 2, 3, 4, 5, 6, 7);
        o[db] = MFMA32(vf, pf, o[db]);
      }
    }
#pragma unroll
    for (int s = 0; s < 4; ++s) kf[s] = kn[s];
    if (__ballot(carry < -60.0f) == ~0ull) break;
  }
#pragma unroll
  for (int db = 0; db < 2; ++db)
#pragma unroll
    for (int g = 0; g < 4; ++g) {
      u32x2 ov; ov[0] = pack2(o[db][4 * g], o[db][4 * g + 1]); ov[1] = pack2(o[db][4 * g + 2], o[db][4 * g + 3]);
      *(u32x2*)(Ya + (size_t)(b * SEQ + tq) * 1024 + 512 + hd * 64 + 32 * db + 8 * g + 4 * h) = ov;
    }
}

DI unsigned sortable(float v) {
  v = v + 0.0f;
  const unsigned u = __float_as_uint(v);
  return (u & 0x80000000u) ? ~u : (u | 0x80000000u);
}

typedef short s16x2_t __attribute__((ext_vector_type(2)));
DI float tile_score(const bf16x8& af, const bf16x8& kf, const s16x4& wa) {
  f32x4 ac = {0.f, 0.f, 0.f, 0.f};
  ac = MFMA16(af, kf, ac);
  const s16x2_t z2 = {0, 0};
  const s16x2_t r01 = __builtin_elementwise_max(__builtin_bit_cast(s16x2_t, pack2(ac[0], ac[1])), z2);
  const s16x2_t r23 = __builtin_elementwise_max(__builtin_bit_cast(s16x2_t, pack2(ac[2], ac[3])), z2);
  s16x4 rb; rb[0] = r01[0]; rb[1] = r01[1]; rb[2] = r23[0]; rb[3] = r23[1];
  f32x4 sc4 = {0.f, 0.f, 0.f, 0.f};
  sc4 = __builtin_amdgcn_mfma_f32_16x16x16bf16_1k(wa, rb, sc4, 0, 0, 0);
  return sc4[0];
}

DI int count_ge8(unsigned a0, unsigned a1, unsigned a2, unsigned a3, unsigned a4, unsigned a5, unsigned a6, unsigned a7, unsigned cand) {
  unsigned long long m0, m1, m2, m3, m4, m5, m6, m7;
  asm("v_cmp_ge_u32_e64 %0, %8, %16\n\tv_cmp_ge_u32_e64 %1, %9, %16\n\tv_cmp_ge_u32_e64 %2, %10, %16\n\tv_cmp_ge_u32_e64 %3, %11, %16\n\t"
      "v_cmp_ge_u32_e64 %4, %12, %16\n\tv_cmp_ge_u32_e64 %5, %13, %16\n\tv_cmp_ge_u32_e64 %6, %14, %16\n\tv_cmp_ge_u32_e64 %7, %15, %16"
      : "=s"(m0), "=s"(m1), "=s"(m2), "=s"(m3), "=s"(m4), "=s"(m5), "=s"(m6), "=s"(m7)
      : "v"(a0), "v"(a1), "v"(a2), "v"(a3), "v"(a4), "v"(a5), "v"(a6), "v"(a7), "v"(cand));
  return (__builtin_popcountll(m0) + __builtin_popcountll(m1)) + (__builtin_popcountll(m2) + __builtin_popcountll(m3))
       + (__builtin_popcountll(m4) + __builtin_popcountll(m5)) + (__builtin_popcountll(m6) + __builtin_popcountll(m7));
}

DI void count_ge8_pair(unsigned a0, unsigned a1, unsigned a2, unsigned a3, unsigned a4, unsigned a5, unsigned a6, unsigned a7, unsigned cand, int& ca, int& cb) {
  unsigned long long m0, m1, m2, m3, m4, m5, m6, m7;
  asm("v_cmp_ge_u32_e64 %0, %8, %16\n\tv_cmp_ge_u32_e64 %1, %9, %16\n\tv_cmp_ge_u32_e64 %2, %10, %16\n\tv_cmp_ge_u32_e64 %3, %11, %16\n\t"
      "v_cmp_ge_u32_e64 %4, %12, %16\n\tv_cmp_ge_u32_e64 %5, %13, %16\n\tv_cmp_ge_u32_e64 %6, %14, %16\n\tv_cmp_ge_u32_e64 %7, %15, %16"
      : "=s"(m0), "=s"(m1), "=s"(m2), "=s"(m3), "=s"(m4), "=s"(m5), "=s"(m6), "=s"(m7)
      : "v"(a0), "v"(a1), "v"(a2), "v"(a3), "v"(a4), "v"(a5), "v"(a6), "v"(a7), "v"(cand));
#define PCLO(m) __builtin_popcount((unsigned)(m))
#define PCHI(m) __builtin_popcount((unsigned)((m) >> 32))
  ca += (PCLO(m0) + PCLO(m1)) + (PCLO(m2) + PCLO(m3)) + (PCLO(m4) + PCLO(m5)) + (PCLO(m6) + PCLO(m7));
  cb += (PCHI(m0) + PCHI(m1)) + (PCHI(m2) + PCHI(m3)) + (PCHI(m4) + PCHI(m5)) + (PCHI(m6) + PCHI(m7));
}

DI void mixB_pair(const Params& p, int tokenA, char* smem, int lane, int w) {
  char* ws = p.ws; asm volatile("" : "+s"(ws));
  const bf16_t* qb = (const bf16_t*)(ws + OFF_QB); const bf16_t* kb = (const bf16_t*)(ws + OFF_KB);
  const bf16_t* vb = (const bf16_t*)(ws + OFF_VB); const bf16_t* qi = (const bf16_t*)(ws + OFF_QI);
  const bf16_t* ki = (const bf16_t*)(ws + OFF_KI); const float* wi = (const float*)(ws + OFF_WI);
  bf16_t* Yb = (bf16_t*)(ws + OFF_YA);
  char* wl_ = smem + w * WAVE_LDS;
  int* sidxA = (int*)wl_;
  int* sidxB = (int*)(wl_ + 16384);
  float* spl = (float*)(wl_ + 1024);
  bf16_t* pbf = (bf16_t*)(wl_ + 6144);
  char* vimg = wl_ + 8192;
  const int b = tokenA >> 12, pos = tokenA & 4095, qc = pos >> 6;
  const int nkeys = (qc + 1) * 64, nk64 = qc + 1;
  const int cntsel = nkeys <= 256 ? nkeys : 256;
  if (nkeys <= 256) {
    for (int s = lane; s < 256; s += 64) { const int v = (s < nkeys) ? s : 0; sidxA[s] = v; sidxB[s] = v; }
  } else {
    const int l15 = lane & 15, l4 = lane >> 4;
    const bool second = lane >= 32;
    const bf16x8 af = *(const bf16x8*)(qi + (size_t)(tokenA + (l15 >> 3)) * 256 + (l15 & 7) * 32 + 8 * l4);
    s16x4 wa;
    {
      const f32x4 wq = *(const f32x4*)(wi + (size_t)(tokenA + (l15 >> 3)) * 8 + 4 * (l4 & 1));
      const bool on = (l15 >> 3) == (l4 >> 1);
      u32x2 wp; wp[0] = on ? pack2(wq[0], wq[1]) : 0u; wp[1] = on ? pack2(wq[2], wq[3]) : 0u;
      wa = __builtin_bit_cast(s16x4, wp);
    }
    const char* kibase = (const char*)ki + (size_t)b * SEQ * 64;
    const unsigned kioff = (unsigned)(lane * 16);
    unsigned u[128];
#pragma unroll
    for (int i = 0; i < 128; ++i) u[i] = 0u;
#pragma unroll
    for (int c = 0; c < 16; ++c) {
      if (c * 4 < nk64) {
        bf16x8 kf[16];
#pragma unroll
        for (int t = 0; t < 16; ++t) kf[t] = *(const bf16x8*)(kibase + (size_t)(c * 16 + t) * 1024 + kioff);
#pragma unroll
        for (int rr = 0; rr < 8; ++rr) {
          const float s0 = tile_score(af, kf[2 * rr], wa), s1 = tile_score(af, kf[2 * rr + 1], wa);
          const float sv = (l4 & 1) ? s1 : s0;
          u[c * 8 + rr] = (c * 4 + (rr >> 1) < nk64) ? sortable(sv) : 0u;
        }
        __builtin_amdgcn_sched_barrier(0);
      }
    }
    unsigned thr = 0u;
    bool doneA = false, doneB = false;
    for (int bit = 31; bit >= 0; --bit) {
      const unsigned cand = thr | (1u << bit);
      int ca = 0, cb = 0;
#pragma unroll
      for (int c = 0; c < 16; ++c) {
        if (c * 4 < nk64) count_ge8_pair(u[c * 8], u[c * 8 + 1], u[c * 8 + 2], u[c * 8 + 3], u[c * 8 + 4], u[c * 8 + 5], u[c * 8 + 6], u[c * 8 + 7], cand, ca, cb);
      }
      const bool accA = ca >= 256, accB = cb >= 256;
      thr = (second ? accB : accA) ? cand : thr;
      doneA = doneA || (ca == 256); doneB = doneB || (cb == 256);
      if (doneA && doneB) break;
    }
    int* mylist = second ? sidxB : sidxA;
    const int keylo = 16 * (l4 & 1) + l15;
    int bA = 0, bB = 0;
#pragma unroll
    for (int c = 0; c < 16; ++c) {
      if (c * 4 < nk64) {
#pragma unroll
        for (int i = c * 8; i < c * 8 + 8; ++i) {
          const unsigned long long m = __ballot(u[i] > thr);
          const unsigned mlo = (unsigned)m, mhi = (unsigned)(m >> 32);
          const int plo = __builtin_popcount(mlo), phi = __builtin_popcount(mhi);
          const int pre = __builtin_amdgcn_mbcnt_hi(mhi, __builtin_amdgcn_mbcnt_lo(mlo, 0u)) - (second ? plo : 0);
          if (u[i] > thr) mylist[(second ? bB : bA) + pre] = 32 * i + keylo;
          bA += plo; bB += phi;
        }
      }
    }
    if (bA < 256 || bB < 256) {
      int eA = bA, eB = bB;
#pragma unroll
      for (int c = 0; c < 16; ++c) {
        if (c * 4 < nk64) {
#pragma unroll
          for (int i = c * 8; i < c * 8 + 8; ++i) {
            const unsigned long long m = __ballot(u[i] == thr);
            const unsigned mlo = (unsigned)m, mhi = (unsigned)(m >> 32);
            const int plo = __builtin_popcount(mlo), phi = __builtin_popcount(mhi);
            const int posn = (second ? eB : eA) + __builtin_amdgcn_mbcnt_hi(mhi, __builtin_amdgcn_mbcnt_lo(mlo, 0u)) - (second ? plo : 0);
            if (u[i] == thr && posn < 256) mylist[posn] = 32 * i + keylo;
            eA += plo; eB += phi;
          }
        }
      }
    }
  }
#pragma unroll 1
  for (int qsel = 0; qsel < 2; ++qsel) {
    const int token = tokenA + qsel;
    if (qsel == 1) {
      __builtin_amdgcn_fence(__ATOMIC_ACQ_REL, "wavefront");
      for (int s = lane; s < 256; s += 64) sidxA[s] = sidxB[s];
    }
    const int* sidx = sidxA;
  __builtin_amdgcn_fence(__ATOMIC_ACQ_REL, "wavefront");
  asm volatile("" : "+v"(lane));
  const int l15 = lane & 15, l4 = lane >> 4;
#pragma unroll 1
  for (int g = 0; g < 2; ++g) {
    bf16x8 qf0, qf1;
    {
      const bf16_t* qp = qb + (size_t)token * 512 + (g * 4 + (lane & 3)) * 64 + 8 * l4;
      qf0 = *(const bf16x8*)qp; qf1 = *(const bf16x8*)(qp + 32);
    }
    const char* kbbase = (const char*)kb + ((size_t)b * SEQ * 128 + g * 64) * 2;
    float mx[4] = {-INFINITY, -INFINITY, -INFINITY, -INFINITY};
    {
      const int ksl_ = lane >> 3, dch_ = lane & 7;
      u32x4 kk[32];
#pragma unroll
      for (int j = 0; j < 32; ++j) {
        const int key = sidx[j * 8 + ksl_];
        kk[j] = *(const u32x4*)(kbbase + (unsigned)(key * 256 + dch_ * 16));
      }
#pragma unroll
      for (int c = 0; c < 4; ++c) {
#pragma unroll
        for (int jj = 0; jj < 8; ++jj) {
          const int row = 8 * jj + ksl_;
          *(u32x4*)(vimg + row * 128 + ((dch_ ^ ((row >> 1) & 7)) * 16)) = kk[c * 8 + jj];
        }
        __builtin_amdgcn_fence(__ATOMIC_ACQ_REL, "wavefront");
#pragma unroll
        for (int tt = 0; tt < 4; ++tt) {
          const int t = c * 4 + tt;
          const int row = 16 * tt + l15, sw = (row >> 1) & 7;
          const bf16x8 k0 = *(const bf16x8*)(vimg + row * 128 + ((l4 ^ sw) * 16));
          const bf16x8 k1 = *(const bf16x8*)(vimg + row * 128 + (((4 + l4) ^ sw) * 16));
          f32x4 ac = {0.f, 0.f, 0.f, 0.f};
          ac = MFMA16(qf0, k0, ac);
          ac = MFMA16(qf1, k1, ac);
          const bool ok = (t * 16 + l15) < cntsel;
          f32x4 lgv;
#pragma unroll
          for (int i = 0; i < 4; ++i) { lgv[i] = ok ? ac[i] * 0.125f : -INFINITY; mx[i] = fmaxf(mx[i], lgv[i]); }
          float* dstp = (l4 == (t & 3)) ? (spl + (t * 16 + l15) * 4) : (spl + 1024 + lane * 4);
          *(f32x4*)dstp = lgv;
        }
        __builtin_amdgcn_fence(__ATOMIC_ACQ_REL, "wavefront");
      }
    }
    __builtin_amdgcn_sched_barrier(0);
    const int ksl = lane >> 3, dch = lane & 7;
    const char* vbase = (const char*)vb + ((size_t)b * SEQ * 128 + g * 64) * 2;
    u32x4 vv[32];
#pragma unroll
    for (int j = 0; j < 32; ++j) {
      const int key = sidx[j * 8 + ksl];
      vv[j] = *(const u32x4*)(vbase + (unsigned)(key * 256 + dch * 16));
    }
    __builtin_amdgcn_sched_barrier(0);
#pragma unroll
    for (int i = 0; i < 4; ++i) {
#pragma unroll
      for (int o = 1; o < 16; o <<= 1) mx[i] = fmaxf(mx[i], __shfl_xor(mx[i], o));
    }
    __builtin_amdgcn_fence(__ATOMIC_ACQ_REL, "wavefront");
    float sm[4] = {0.f, 0.f, 0.f, 0.f};
    {
      f32x4 lgq[4];
#pragma unroll
      for (int jj = 0; jj < 4; ++jj) lgq[jj] = *(const f32x4*)(spl + (4 * lane + jj) * 4);
#pragma unroll
      for (int i = 0; i < 4; ++i) {
        float pq[4];
#pragma unroll
        for (int jj = 0; jj < 4; ++jj) { pq[jj] = __expf(lgq[jj][i] - mx[i]); sm[i] += pq[jj]; }
        u32x2 w2; w2[0] = pack2(pq[0], pq[1]); w2[1] = pack2(pq[2], pq[3]);
        *(u32x2*)(pbf + i * 256 + 4 * lane) = w2;
      }
    }
#pragma unroll
    for (int i = 0; i < 4; ++i) {
#pragma unroll
      for (int o = 1; o < 64; o <<= 1) sm[i] += __shfl_xor(sm[i], o);
    }
    __builtin_amdgcn_fence(__ATOMIC_ACQ_REL, "wavefront");
    f32x4 oacc[4];
#pragma unroll
    for (int d = 0; d < 4; ++d) oacc[d] = (f32x4){0.f, 0.f, 0.f, 0.f};
    typedef __attribute__((address_space(3))) s16x4 lds_s16x4;
    const int tq = l15 >> 2, tp = l15 & 3;
#pragma unroll
    for (int c = 0; c < 4; ++c) {
#pragma unroll
      for (int jj = 0; jj < 8; ++jj) {
        const int row = 8 * jj + ksl, sw = ((row >> 1) & 1) | (((row >> 3) & 1) << 1);
        *(u32x4*)(vimg + row * 128 + ((dch ^ (sw << 1)) * 16)) = vv[c * 8 + jj];
      }
      __builtin_amdgcn_fence(__ATOMIC_ACQ_REL, "wavefront");
#pragma unroll
      for (int ks = 0; ks < 2; ++ks) {
        const bf16x8 pb = *(const bf16x8*)(pbf + (l15 & 3) * 256 + c * 64 + ks * 32 + 8 * l4);
#pragma unroll
        for (int d = 0; d < 4; ++d) {
          const int vrow_ = ks * 32 + 8 * l4 + tq, vsw_ = ((vrow_ >> 1) & 1) | (((vrow_ >> 3) & 1) << 1);
          const char* ap = vimg + vrow_ * 128 + (((d * 4 + tp) ^ (vsw_ << 2)) * 8);
          const s16x4 lo = __builtin_amdgcn_ds_read_tr16_b64_v4i16((lds_s16x4*)ap);
          const s16x4 hi = __builtin_amdgcn_ds_read_tr16_b64_v4i16((lds_s16x4*)(ap + 512));
          const bf16x8 va8 = __builtin_shufflevector(lo, hi, 0, 1, 2, 3, 4, 5, 6, 7);
          oacc[d] = MFMA16(va8, pb, oacc[d]);
        }
      }
      __builtin_amdgcn_fence(__ATOMIC_ACQ_REL, "wavefront");
    }
    {
      const int hd_ = l15 & 3;
      const float ssel = hd_ == 0 ? sm[0] : (hd_ == 1 ? sm[1] : (hd_ == 2 ? sm[2] : sm[3]));
      const float inv = 1.0f / ssel;
      if (l15 < 4) {
#pragma unroll
        for (int d = 0; d < 4; ++d) {
          u32x2 o; o[0] = pack2(oacc[d][0] * inv, oacc[d][1] * inv); o[1] = pack2(oacc[d][2] * inv, oacc[d][3] * inv);
          *(u32x2*)(Yb + (size_t)token * 1024 + (g * 4 + hd_) * 64 + d * 16 + 4 * l4) = o;
        }
      }
    }
    __builtin_amdgcn_fence(__ATOMIC_ACQ_REL, "wavefront");
  }

  }
}

DI void phase_mixers(const Params& p, char* smem) {
  const int tid = otid(), lane = tid & 63, w = __builtin_amdgcn_readfirstlane(tid >> 6);
  const int nwv = gridDim.x * NWAVE;
  const int wv = blockIdx.x * NWAVE + w;
  int itA = wv, jp = wv;
#pragma unroll 1
  for (int k = 0; itA < 64 * (SEQ / 32) || jp < T_TOK / 2; ++k) {
    if (itA < 64 * (SEQ / 32) && ((k & 1) == 0 || jp >= T_TOK / 2)) { mixA_wave(p, itA, lane); itA += nwv; }
    if (jp < T_TOK / 2) {
      const int bat = jp / (SEQ / 2), pidx = jp & (SEQ / 2 - 1);
      const int ppos = (bat & 1) ? (SEQ / 2 - 1 - pidx) : pidx;
      mixB_pair(p, bat * SEQ + 2 * ppos, smem, lane, w);
      jp += nwv;
    }
  }
  __syncthreads();
}

__global__ void __launch_bounds__(512) fwd_megakernel(Params p) {
  cg::grid_group grid = cg::this_grid();
  __shared__ __attribute__((aligned(1024))) char smem[LDS_BYTES];
  if (p.out == nullptr) grid.sync();
  __shared__ uint4 xb_words;
  if (otid() == 0) xb_words = make_uint4(0u, 0u, 0u, 0u);
  __syncthreads();
  const XcdBarrier xb = xcd_barrier_post((unsigned*)(p.ws + OFF_BAR), (volatile LAS unsigned*)&xb_words);
  phase_prep(p, smem);
  phase_rmsnorm<false, false>(p.x, p.g_mix, (bf16_t*)(p.ws + OFF_HBUF), nullptr);
  xcd_barrier(xb);
  bf16_t* xs = (bf16_t*)p.out;
#pragma unroll 1
  for (int layer = 0; layer < 2; ++layer) {
    char* wl = p.ws + (size_t)layer * WT_LAYER;
    bf16_t* hbuf = (bf16_t*)(p.ws + OFF_HBUF);
    if (layer > 0) {
      phase_rmsnorm<true, false>(xs, p.g_mix + DM, hbuf, nullptr);
      xcd_barrier(xb);
    }
    { EpiInproj E; E.ws = p.ws; run_gemm(smem, hbuf, (const bf16_t*)(wl + WT_IN), NPAD_IN, 1024, E); }
    xcd_barrier(xb);
    phase_mixers(p, smem);
    xcd_barrier(xb);
    { EpiMergeFused E; E.gates = (const bf16_t*)(p.ws + OFF_GATES); E.O = hbuf;
      run_gemm(smem, (const bf16_t*)(p.ws + OFF_YA), (const bf16_t*)(wl + WT_UPA), 1024, 1024, E); }
    xcd_barrier(xb);
    if (layer == 0) { EpiResid<true> E; E.R = p.x; E.O = xs; run_gemm(smem, hbuf, (const bf16_t*)(wl + WT_O), 1024, 1024, E); }
    else            { EpiResid<false> E; E.R = xs; E.O = xs; run_gemm(smem, hbuf, (const bf16_t*)(wl + WT_O), 1024, 1024, E); }
    xcd_barrier(xb);
    phase_rmsnorm<true, false>(xs, p.g_mlp + layer * DM, hbuf, nullptr);
    xcd_barrier(xb);
    { EpiSqrelu E; E.O = (bf16_t*)(p.ws + OFF_HIDDEN); run_gemm(smem, hbuf, (const bf16_t*)(wl + WT_FF1), 4096, 1024, E); }
    xcd_barrier(xb);
    { EpiResid<false> E; E.R = xs; E.O = layer == 0 ? xs : hbuf; run_gemm(smem, (const bf16_t*)(p.ws + OFF_HIDDEN), (const bf16_t*)(wl + WT_FF2), 1024, 4096, E); }
    xcd_barrier(xb);
  }
  phase_rmsnorm<true, true>((const bf16_t*)(p.ws + OFF_HBUF), p.g_final, nullptr, p.out);
}

extern "C" void kernel_launch(void* const* d_in, const int* in_sizes, int n_in,
                              void* d_out, int out_size, void* d_ws, size_t ws_size,
                              hipStream_t stream) {
  static int grid_blocks = 0;
  if (!grid_blocks) {
    int dev = 0, cus = 0, per_cu = 0;
    (void)hipGetDevice(&dev);
    (void)hipDeviceGetAttribute(&cus, hipDeviceAttributeMultiprocessorCount, dev);
    (void)hipOccupancyMaxActiveBlocksPerMultiprocessor(&per_cu, fwd_megakernel, NTHR, 0);
    if (per_cu > 1) per_cu = 1;
    if (per_cu < 1) per_cu = 1;
    grid_blocks = cus * per_cu;
  }
  Params p{};
  p.x = (const float*)d_in[0]; p.g_mix = (const float*)d_in[1]; p.w_in = (const float*)d_in[2];
  p.w_up_a = (const float*)d_in[3]; p.w_up_b = (const float*)d_in[4]; p.w_o = (const float*)d_in[5];
  p.g_mlp = (const float*)d_in[6]; p.w_ff1 = (const float*)d_in[7]; p.w_ff2 = (const float*)d_in[8];
  p.g_final = (const float*)d_in[9];
  p.out = (float*)d_out; p.ws = (char*)d_ws;
  (void)hipMemsetAsync((char*)d_ws + OFF_BAR, 0, XCD_BAR_WORDS * 4, stream);
  void* args[] = {&p};
  hipError_t e = hipLaunchCooperativeKernel((void*)fwd_megakernel, dim3(grid_blocks), dim3(NTHR), args, 0, stream);
  if (e != hipSuccess) fprintf(stderr, "cooperative launch failed: %s (grid %d)\n", hipGetErrorString(e), grid_blocks);
}
```

```cpp
#include <hip/hip_runtime.h>
#include <hip/hip_bf16.h>
#include <hip/hip_cooperative_groups.h>
#include <cstdio>
namespace cg = cooperative_groups;

#define DI __device__ __forceinline__
typedef __bf16 bf2_t __attribute__((ext_vector_type(2)));
typedef float fl2_t __attribute__((ext_vector_type(2)));
DI int otid() { int t = threadIdx.x; asm volatile("" : "+v"(t)); return t; }

#define XB_TMO      128
#define XB_XCNT(j)  (256  + 64 * (j))
#define XB_XSUB(j)  (1280 + 64 * (j))
#define XB_XGEN(j)  (2304 + 64 * (j))
#define XB_TOP      3328
#define XB_TOPGEN   3392
#define XCD_BAR_WORDS 3456
#define XB_SPIN_CAP (1u << 18)
#define LAS __attribute__((address_space(3)))

__device__ __forceinline__ unsigned xb_ld(unsigned* p)              { return __hip_atomic_load(p, __ATOMIC_RELAXED, __HIP_MEMORY_SCOPE_AGENT); }
__device__ __forceinline__ unsigned xb_add(unsigned* p, unsigned v) { return __hip_atomic_fetch_add(p, v, __ATOMIC_RELAXED, __HIP_MEMORY_SCOPE_AGENT); }
__device__ __forceinline__ unsigned xb_xcc_id() { return (unsigned)__builtin_amdgcn_s_getreg((3 << 11) | 20) & 0xFu; }
#define XB_SPIN(cond, bar) do { unsigned _sp = 0; while (cond) { __builtin_amdgcn_s_sleep(1); \
    if ((++_sp & 255u) == 0u) { if (xb_ld(&(bar)[XB_TMO])) break; if (_sp > XB_SPIN_CAP) { atomicAdd(&(bar)[XB_TMO], 1u); break; } } } } while (0)

struct XcdBarrier {
    unsigned* bar; unsigned x;
    volatile LAS unsigned* st;
};

__device__ __forceinline__ XcdBarrier xcd_barrier_post(unsigned* bar, volatile LAS unsigned* st) {
    XcdBarrier b; b.bar = bar; b.x = xb_xcc_id(); b.st = st;
    if (otid() == 0) (void)xb_add(&bar[XB_XCNT(b.x)], 1u);
    return b;
}
__device__ __forceinline__ void xcd_barrier_complete(unsigned* bar, unsigned x, unsigned& nloc, unsigned& nx) {
    const unsigned G = gridDim.x * gridDim.y * gridDim.z;
    unsigned sum, cnt, mine, sp = 0u;
    for (;;) {
        sum = 0u; cnt = 0u; mine = 0u;
#pragma unroll
        for (unsigned j = 0; j < 16; ++j) { const unsigned c = xb_ld(&bar[XB_XCNT(j)]); sum += c; cnt += (c > 0u) ? 1u : 0u; mine = (j == x) ? c : mine; }
        if (sum == G) break;
        __builtin_amdgcn_s_sleep(1);
        if ((++sp & 255u) == 0u) { if (xb_ld(&bar[XB_TMO])) break; if (sp > XB_SPIN_CAP) { atomicAdd(&bar[XB_TMO], 1u); break; } }
    }
    nloc = mine > 0u ? mine : 1u; nx = cnt > 0u ? cnt : 1u;
}

__device__ __forceinline__ void xcd_barrier(const XcdBarrier& b) {
    asm volatile("s_waitcnt vmcnt(0)" ::: "memory");
    __syncthreads();
    if (otid() == 0) {
        unsigned* bar = b.bar; unsigned bx_ = b.x;
        asm volatile("" : "+s"(bar), "+s"(bx_));
        __builtin_amdgcn_s_waitcnt(0);
        unsigned nloc = b.st[0], nx = b.st[1];
        if (nloc == 0u) { xcd_barrier_complete(bar, bx_, nloc, nx); b.st[0] = nloc; b.st[1] = nx; }
        const unsigned old = xb_add(&bar[XB_XSUB(bx_)], 1u);
        const unsigned gen = old / nloc;
        if (old + 1u == (gen + 1u) * nloc) {
            __builtin_amdgcn_fence(__ATOMIC_RELEASE, "agent");
            asm volatile("s_waitcnt vmcnt(0)" ::: "memory");
            const unsigned og = xb_add(&bar[XB_TOP], 1u);
            const unsigned tg = og / nx;
            if (og + 1u == (tg + 1u) * nx) xb_add(&bar[XB_TOPGEN], 1u);
            else XB_SPIN(xb_ld(&bar[XB_TOPGEN]) == tg, bar);
            __builtin_amdgcn_fence(__ATOMIC_ACQUIRE, "agent");
            xb_add(&bar[XB_XGEN(bx_)], 1u);
            asm volatile("s_waitcnt vmcnt(0)" ::: "memory");
        } else {
            XB_SPIN(xb_ld(&bar[XB_XGEN(bx_)]) == gen, bar);
            __builtin_amdgcn_fence(__ATOMIC_ACQUIRE, "agent");
            asm volatile("s_waitcnt vmcnt(0)" ::: "memory");
        }
    }
    __syncthreads();
}

namespace pg8 {
#define PG8_LAS __attribute__((address_space(3)))
typedef unsigned short bf16_t;
typedef short bf16x8 __attribute__((ext_vector_type(8)));
typedef float f32x4 __attribute__((ext_vector_type(4)));
typedef unsigned u32x4 __attribute__((ext_vector_type(4)));
constexpr int BM = 256, BK = 64, HALF = 128, HTB = HALF * BK * 2  , STAGE_BYTES = 8 * HTB, NXCD = 8, WGM = 2;

__host__ __device__ __forceinline__ int lds_byte(int r, int c) { const int st = (r >> 4) * 2 + (c >> 5), rr = r & 15, cc = c & 31, ob = rr * 64 + cc * 2; return st * 1024 + (ob ^ (((ob >> 9) & 1) << 5)); }
__host__ __device__ __forceinline__ void stage_rc(int b, int& R, int& C) { const int st = b / 1024, sb = b % 1024, swz = sb ^ (((sb >> 9) & 1) << 5); R = (st >> 1) * 16 + swz / 64; C = (st & 1) * 32 + (swz % 64) / 2; }
__host__ __device__ __forceinline__ int perm32(int rho) { const int n = rho >> 4, i = rho & 15; return 8 * (i >> 2) + 4 * n + (i & 3); }

struct Unit { int pm, pn; };
struct Gemm { const bf16_t* A; const bf16_t* Bt; int M, N, K; };
struct StaticOrder {
    int nM, nN, nwg, G, c;
    __host__ __device__ void init(int M, int N, int G_, int c_) { nM = M / BM; nN = N / BM; nwg = nM * nN; G = G_; c = c_; }
    __host__ __device__ bool next(int i, Unit& u) const {
        const long L = (long)i * G + c; if (L >= nwg) return false;
        int wgid = (int)L; { const int q = nwg / NXCD, r = nwg % NXCD, xcd = wgid % NXCD, off = wgid / NXCD; wgid = (xcd < r ? xcd * (q + 1) : r * (q + 1) + (xcd - r) * q) + off; }
        const int nig = WGM * nN, gid = wgid / nig, fm = gid * WGM, gsz = (nM - fm) < WGM ? (nM - fm) : WGM;
        u.pm = fm + ((wgid % nig) % gsz); u.pn = (wgid % nig) / gsz; return true;
    }
    __device__ __forceinline__ void a_ready(const Unit&) const {}
    __device__ __forceinline__ void done(const Unit&) const {}
};
template <class Epi, class Sched, bool STAMP = false>
__device__ __forceinline__ void gemm_phase(PG8_LAS unsigned char* lds, const Gemm g, const Sched& S, const Epi& E, unsigned long long* stamps) {
    const int tid = otid(), wid = __builtin_amdgcn_readfirstlane(tid >> 6), lane = tid & 63, wr = wid >> 2, wc = wid & 3, fr = lane & 15, fq = lane >> 4;
    const int K = g.K, nt = K / BK;
    int ts_lo = 0, ts_hi = 0, nts = 0; const unsigned long long rt_entry = STAMP ? (unsigned long long)wall_clock64() : 0ull;
#define PG8_STAMP() do { if (STAMP && wid == 0 && nts < 64) { const unsigned long long _c = (unsigned long long)clock64(); \
        ts_lo = (lane == nts) ? (int)(unsigned)_c : ts_lo; ts_hi = (lane == nts) ? (int)(unsigned)(_c >> 32) : ts_hi; ++nts; } } while (0)
    PG8_STAMP();
    unsigned voffA[2], voffB[2];
#pragma unroll
    for (int i = 0; i < 2; ++i) { int R, C; stage_rc(tid * 16 + i * 8192, R, C); const int Rb = Epi::PERM ? ((R & ~31) + perm32(R & 31)) : R;
        voffA[i] = (unsigned)(R * K + C) * 2u; voffB[i] = (unsigned)(Rb * K + C) * 2u; }
    const size_t kstep = (size_t)(BK * 2);
    const size_t hstep = (size_t)HALF * K * 2;
    const size_t tstep = 2 * hstep;
    const unsigned ldsw = (unsigned)wid * 1024u;
    const int aoff = lds_byte(wr * 64 + fr, fq * 8), boff = lds_byte(wc * 32 + fr, fq * 8);
#define PG8_SA(b, h) (((b) * 2 + (h)) * HTB)
#define PG8_SB(b, h) ((4 + (b) * 2 + (h)) * HTB)
#define PG8_STAGE(bufoff, gbase, voff) do { _Pragma("unroll") for (int _i = 0; _i < 2; ++_i) \
        __builtin_amdgcn_global_load_lds((const unsigned*)((const char*)(gbase) + (voff)[_i]), (PG8_LAS unsigned*)(lds + (bufoff) + ldsw + _i * 8192), 16, 0, 0); } while (0)
#define PG8_LDA(dst, b, h) do { _Pragma("unroll") for (int m = 0; m < 4; ++m) _Pragma("unroll") for (int k = 0; k < 2; ++k) dst[m][k] = *(const PG8_LAS bf16x8*)(lds + PG8_SA(b, h) + aoff + m * 2048 + k * 1024); } while (0)
#define PG8_LDB(dst, b, h) do { _Pragma("unroll") for (int n = 0; n < 2; ++n) _Pragma("unroll") for (int k = 0; k < 2; ++k) dst[n][k] = *(const PG8_LAS bf16x8*)(lds + PG8_SB(b, h) + boff + n * 2048 + k * 1024); } while (0)
#define PG8_MMA(ai, bj, At, Bt) do { __builtin_amdgcn_s_setprio(1); _Pragma("unroll") for (int m = 0; m < 4; ++m) _Pragma("unroll") for (int n = 0; n < 2; ++n) _Pragma("unroll") for (int k = 0; k < 2; ++k) \
        acc[ai][bj][m][n] = __builtin_amdgcn_mfma_f32_16x16x32_bf16(Bt[n][k], At[m][k], acc[ai][bj][m][n], 0, 0, 0); __builtin_amdgcn_s_setprio(0); } while (0)
#define PG8_WAIT_V(n) asm volatile("s_waitcnt vmcnt(" #n ")" ::: "memory")
#define PG8_WAIT_L(n) asm volatile("s_waitcnt lgkmcnt(" #n ")" ::: "memory")
#define PG8_BAR __builtin_amdgcn_s_barrier()
#define PG8_SCHED __builtin_amdgcn_sched_barrier(0)
    Unit cur, nxt; int ui = 0;
    if (!S.next(0, cur)) return;
    f32x4 acc[2][2][4][2];
#pragma unroll
    for (int a = 0; a < 2; ++a)
#pragma unroll
        for (int b = 0; b < 2; ++b)
#pragma unroll
            for (int m = 0; m < 4; ++m)
#pragma unroll
                for (int n = 0; n < 2; ++n) acc[a][b][m][n] = (f32x4){0.f, 0.f, 0.f, 0.f};
    bf16x8 At[4][2], B0[2][2], B1[2][2];
    const char* cA = (const char*)g.A + (size_t)cur.pm * tstep; const char* cB = (const char*)g.Bt + (size_t)cur.pn * tstep;
    S.a_ready(cur);
    PG8_STAGE(PG8_SB(0, 0), cB, voffB); PG8_STAGE(PG8_SA(0, 0), cA, voffA); PG8_STAGE(PG8_SB(0, 1), cB + hstep, voffB); PG8_STAGE(PG8_SA(0, 1), cA + hstep, voffA);
    if (wr == 1) PG8_BAR;
    PG8_WAIT_V(4); PG8_BAR;
    PG8_STAGE(PG8_SB(1, 0), cB + kstep, voffB); PG8_STAGE(PG8_SA(1, 0), cA + kstep, voffA); PG8_STAGE(PG8_SB(1, 1), cB + hstep + kstep, voffB);
    PG8_WAIT_V(6); PG8_BAR;
    PG8_STAMP();
    for (;;) {
        const bool has_next = S.next(ui + 1, nxt);
        const char* nA = has_next ? (const char*)g.A + (size_t)nxt.pm * tstep : cA; const char* nB = has_next ? (const char*)g.Bt + (size_t)nxt.pn * tstep : cB;
        for (int t = 0; t < nt; t += 2) {
            if constexpr (Epi::MIDK) { if (t == nt / 2) E.mid(acc, cur, wr, wc, fr, fq); }
            const bool last = (t == nt - 2);
            const char* a1 = cA + (size_t)(t + 1) * kstep;
            const char* a2 = last ? nA : cA + (size_t)(t + 2) * kstep; const char* b2 = last ? nB : cB + (size_t)(t + 2) * kstep;
            const char* a3 = a2 + kstep; const char* b3 = b2 + kstep;
            if (last && has_next) S.a_ready(nxt);
            PG8_LDB(B0, 0, 0); PG8_SCHED; PG8_LDA(At, 0, 0); PG8_STAGE(PG8_SA(1, 1), a1 + hstep, voffA);
            PG8_WAIT_L(8); PG8_BAR; PG8_WAIT_L(0); PG8_MMA(0, 0, At, B0); PG8_BAR; PG8_SCHED;
            PG8_LDB(B1, 0, 1); PG8_STAGE(PG8_SB(0, 0), b2, voffB);
            PG8_BAR; PG8_WAIT_L(0); PG8_MMA(0, 1, At, B1); PG8_BAR;
            PG8_LDA(At, 0, 1); PG8_STAGE(PG8_SA(0, 0), a2, voffA);
            PG8_BAR; PG8_WAIT_L(0); PG8_MMA(1, 0, At, B0); PG8_BAR; PG8_SCHED;
            PG8_STAGE(PG8_SB(0, 1), b2 + hstep, voffB);
            PG8_WAIT_V(6); PG8_BAR; PG8_MMA(1, 1, At, B1); PG8_BAR;
            PG8_LDB(B0, 1, 0); PG8_SCHED; PG8_LDA(At, 1, 0); PG8_STAGE(PG8_SA(0, 1), a2 + hstep, voffA);
            PG8_WAIT_L(8); PG8_BAR; PG8_WAIT_L(0); PG8_MMA(0, 0, At, B0); PG8_BAR; PG8_SCHED;
            PG8_LDB(B1, 1, 1); PG8_STAGE(PG8_SB(1, 0), b3, voffB);
            PG8_BAR; PG8_WAIT_L(0); PG8_MMA(0, 1, At, B1); PG8_BAR;
            PG8_LDA(At, 1, 1); PG8_STAGE(PG8_SA(1, 0), a3, voffA);
            PG8_BAR; PG8_WAIT_L(0); PG8_MMA(1, 0, At, B0); PG8_BAR; PG8_SCHED;
            PG8_STAGE(PG8_SB(1, 1), b3 + hstep, voffB);
            PG8_WAIT_V(6); PG8_BAR; PG8_MMA(1, 1, At, B1); PG8_BAR;
        }
        PG8_STAMP();
        if constexpr (!Epi::AFTER_DRAIN) { E(acc, cur, wr, wc, fr, fq); S.done(cur); }
        PG8_STAMP();
        if (!has_next) break;
#pragma unroll
        for (int a = 0; a < 2; ++a)
#pragma unroll
            for (int b = 0; b < 2; ++b)
#pragma unroll
                for (int m = 0; m < 4; ++m)
#pragma unroll
                    for (int n = 0; n < 2; ++n) acc[a][b][m][n] = (f32x4){0.f, 0.f, 0.f, 0.f};
        cur = nxt; cA = nA; cB = nB; ++ui;
    }
    PG8_WAIT_V(0);
    if (wr == 0) PG8_BAR;
    PG8_BAR;
    if constexpr (Epi::AFTER_DRAIN) { E.fused(acc, cur, wr, wc, fr, fq, lds, wid, lane); S.done(cur); }
    PG8_STAMP();
    if (STAMP && wid == 0) { stamps[lane] = lane < nts ? (((unsigned long long)(unsigned)ts_hi << 32) | (unsigned)ts_lo) : 0ull;
        if (lane == 62) stamps[62] = rt_entry; if (lane == 63) stamps[63] = (unsigned long long)wall_clock64(); }
#undef PG8_STAMP
#undef PG8_SA
#undef PG8_SB
#undef PG8_STAGE
#undef PG8_LDA
#undef PG8_LDB
#undef PG8_MMA
#undef PG8_WAIT_V
#undef PG8_WAIT_L
#undef PG8_BAR
#undef PG8_SCHED
}
}

typedef unsigned short bf16_t;
using bf16x8 = __attribute__((ext_vector_type(8))) short;
using s16x4  = __attribute__((ext_vector_type(4))) short;
using f32x16 = __attribute__((ext_vector_type(16))) float;
using f32x4  = __attribute__((ext_vector_type(4))) float;
using u32x4  = __attribute__((ext_vector_type(4))) unsigned;
using u32x2  = __attribute__((ext_vector_type(2))) unsigned;

#define MFMA32(a, b, c) __builtin_amdgcn_mfma_f32_32x32x16_bf16((a), (b), (c), 0, 0, 0)
#define MFMA16(a, b, c) __builtin_amdgcn_mfma_f32_16x16x32_bf16((a), (b), (c), 0, 0, 0)

constexpr int NTHR = 512, NWAVE = 8;
constexpr int T_TOK = 32768, SEQ = 4096, DM = 1024;
constexpr int NPAD_IN = 4864;
constexpr int SROW = 144;
constexpr int WAVE_LDS = 17408;
constexpr int LDS_BYTES = 8 * WAVE_LDS;

constexpr size_t WT_IN = 0;
constexpr size_t WT_UPA = WT_IN + (size_t)NPAD_IN * 1024 * 2;
constexpr size_t WT_UPB = WT_UPA + (size_t)1024 * 512 * 2;
constexpr size_t WT_O   = WT_UPB + (size_t)1024 * 512 * 2;
constexpr size_t WT_FF1 = WT_O + (size_t)1024 * 1024 * 2;
constexpr size_t WT_FF2 = WT_FF1 + (size_t)4096 * 1024 * 2;
constexpr size_t WT_LAYER = WT_FF2 + (size_t)1024 * 4096 * 2;
constexpr size_t OFF_ROPE = 2 * WT_LAYER;
constexpr size_t OFF_QA = OFF_ROPE + (size_t)SEQ * 24 * 4;
constexpr size_t OFF_KA = OFF_QA + (size_t)T_TOK * 512 * 2;
constexpr size_t OFF_VAT = OFF_KA + (size_t)T_TOK * 512 * 2;
constexpr size_t OFF_QB = OFF_VAT + (size_t)T_TOK * 512 * 2;
constexpr size_t OFF_KB = OFF_QB + (size_t)T_TOK * 512 * 2;
constexpr size_t OFF_VB = OFF_KB + (size_t)T_TOK * 128 * 2;
constexpr size_t OFF_QI = OFF_VB + (size_t)T_TOK * 128 * 2;
constexpr size_t OFF_KI = OFF_QI + (size_t)T_TOK * 256 * 2;
constexpr size_t OFF_WI = OFF_KI + (size_t)T_TOK * 32 * 2;
constexpr size_t OFF_GATES = OFF_WI + (size_t)T_TOK * 8 * 4;
constexpr size_t OFF_PROJ_END = OFF_GATES + (size_t)T_TOK * 2048 * 2;
constexpr size_t OFF_HIDDEN = OFF_QA;
constexpr size_t OFF_YA = OFF_PROJ_END;
constexpr size_t OFF_YB = OFF_YA + (size_t)T_TOK * 512 * 2;
constexpr size_t OFF_HBUF = OFF_YB + (size_t)T_TOK * 512 * 2;
constexpr size_t OFF_END = OFF_HBUF + (size_t)T_TOK * 1024 * 2;
constexpr size_t OFF_BAR = OFF_END;
static_assert(OFF_BAR + XCD_BAR_WORDS * 4 <= (size_t)512 * 1024 * 1024, "workspace too large");
static_assert(OFF_HIDDEN + (size_t)T_TOK * 4096 * 2 <= OFF_PROJ_END, "hidden alias");

struct Params {
  const float* x; const float* g_mix; const float* w_in; const float* w_up_a; const float* w_up_b;
  const float* w_o; const float* g_mlp; const float* w_ff1; const float* w_ff2; const float* g_final;
  float* out; char* ws;
};

DI unsigned pack2(float a, float b) {
  fl2_t f = {a, b};
  bf2_t r = __builtin_convertvector(f, bf2_t);
  return __builtin_bit_cast(unsigned, r);
}
DI bf16_t f2bf(float a) { return (bf16_t)(pack2(a, 0.f) & 0xffffu); }
DI float bflo(unsigned w) { return __uint_as_float(w << 16); }
DI float bfhi(unsigned w) { return __uint_as_float(w & 0xffff0000u); }
DI int crow(int reg, int h) { return (reg & 3) + 8 * (reg >> 2) + 4 * h; }
DI u32x4 pack8(const f32x4& a, const f32x4& b) {
  u32x4 w; w[0] = pack2(a[0], a[1]); w[1] = pack2(a[2], a[3]); w[2] = pack2(b[0], b[1]); w[3] = pack2(b[2], b[3]); return w;
}

DI int src_col(int nd, int mode) {
  if (!mode) return nd;
  if (nd < 2560) return nd;
  if (nd < 4608) { const int blk = (nd - 2560) >> 7; return 2600 + (blk & 1) * 1024 + (blk >> 1) * 128 + (nd & 127); }
  if (nd < 4648) return nd - 2048;
  return -1;
}
DI void convT(const float* __restrict__ W, int K, int N, bf16_t* __restrict__ WT, int NR, int mode, char* smem, int ldw = 0, int koff = 0) {
  if (ldw == 0) ldw = K;
  float* tile = (float*)smem;
  const int tid = otid();
  const int kt_n = K / 64, nt_n = NR / 64;
  for (int t = blockIdx.x; t < kt_n * nt_n; t += gridDim.x) {
    const int k0 = (t % kt_n) * 64, n0 = (t / kt_n) * 64;
    const int nl = tid & 63;
    const int sc = src_col(n0 + nl, mode);
    __syncthreads();
#pragma unroll
    for (int r = 0; r < 8; ++r) {
      const int kl = r * 8 + (tid >> 6);
      float v = 0.f;
      if (sc >= 0) v = W[(size_t)(k0 + kl) * N + sc];
      tile[kl * 65 + nl] = v;
    }
    __syncthreads();
    const int nrow = tid >> 3, ks = (tid & 7) * 8;
    u32x4 o0;
#pragma unroll
    for (int j = 0; j < 4; ++j) o0[j] = pack2(tile[(ks + 2 * j) * 65 + nrow], tile[(ks + 2 * j + 1) * 65 + nrow]);
    *(u32x4*)(WT + (size_t)(n0 + nrow) * ldw + koff + k0 + ks) = o0;
  }
}

DI void phase_prep(const Params& p, char* smem) {
  for (int l = 0; l < 2; ++l) {
    char* wl = p.ws + (size_t)l * WT_LAYER;
    convT(p.w_in + (size_t)l * 1024 * 4648, 1024, 4648, (bf16_t*)(wl + WT_IN), NPAD_IN, 1, smem);
    convT(p.w_up_b + (size_t)l * 512 * 1024, 512, 1024, (bf16_t*)(wl + WT_UPA), 1024, 0, smem, 1024, 0);
    convT(p.w_up_a + (size_t)l * 512 * 1024, 512, 1024, (bf16_t*)(wl + WT_UPA), 1024, 0, smem, 1024, 512);
    convT(p.w_o + (size_t)l * 1024 * 1024, 1024, 1024, (bf16_t*)(wl + WT_O), 1024, 0, smem);
    convT(p.w_ff1 + (size_t)l * 1024 * 4096, 1024, 4096, (bf16_t*)(wl + WT_FF1), 4096, 0, smem);
    convT(p.w_ff2 + (size_t)l * 4096 * 1024, 4096, 1024, (bf16_t*)(wl + WT_FF2), 1024, 0, smem);
  }
  float* rope = (float*)(p.ws + OFF_ROPE);
  for (int i = blockIdx.x * NTHR + otid(); i < SEQ * 12; i += gridDim.x * NTHR) {
    const int pos = i / 12, f = i % 12;
    float inv; int co, so;
    if (f < 8) { inv = powf(500000.0f, -((float)(2 * f) / 16.0f)); co = f; so = 8 + f; }
    else { inv = powf(500000.0f, -((float)(2 * (f - 8)) / 8.0f)); co = 16 + (f - 8); so = 20 + (f - 8); }
    const float ang = (float)pos * inv;
    float s, c; sincosf(ang, &s, &c);
    rope[pos * 24 + co] = c; rope[pos * 24 + so] = s;
  }
}

template <bool IN_BF, bool FINAL>
DI void phase_rmsnorm(const void* __restrict__ xin_, const float* __restrict__ g, bf16_t* __restrict__ hout, float* __restrict__ fout) {
  const int tid_ = otid(); const int wave = tid_ >> 6, lane = tid_ & 63;
  for (int t = blockIdx.x * NWAVE + wave; t < T_TOK; t += gridDim.x * NWAVE) {
    float v[16]; float ss = 0.f;
    if (IN_BF) {
      const u32x4* src = (const u32x4*)((const bf16_t*)xin_ + (size_t)t * DM);
#pragma unroll
      for (int i = 0; i < 2; ++i) {
        const u32x4 w4 = src[lane + 64 * i];
#pragma unroll
        for (int j = 0; j < 4; ++j) { v[8 * i + 2 * j] = bflo(w4[j]); v[8 * i + 2 * j + 1] = bfhi(w4[j]); }
      }
    } else {
      const float4* src = (const float4*)((const float*)xin_ + (size_t)t * DM);
#pragma unroll
      for (int i = 0; i < 4; ++i) { const float4 f = src[2 * lane + 128 * (i >> 1) + (i & 1)]; v[4 * i] = f.x; v[4 * i + 1] = f.y; v[4 * i + 2] = f.z; v[4 * i + 3] = f.w; }
    }
#pragma unroll
    for (int k = 0; k < 16; ++k) ss += v[k] * v[k];
#pragma unroll
    for (int o = 32; o > 0; o >>= 1) ss += __shfl_xor(ss, o);
    const float r = rsqrtf(ss * (1.0f / DM) + 1e-6f);
#pragma unroll
    for (int i = 0; i < 2; ++i) {
      const int e0 = (lane + 64 * i) * 8;
      const float4 g0 = *(const float4*)(g + e0), g1 = *(const float4*)(g + e0 + 4);
      float o8[8];
      o8[0] = v[8 * i] * r * g0.x; o8[1] = v[8 * i + 1] * r * g0.y; o8[2] = v[8 * i + 2] * r * g0.z; o8[3] = v[8 * i + 3] * r * g0.w;
      o8[4] = v[8 * i + 4] * r * g1.x; o8[5] = v[8 * i + 5] * r * g1.y; o8[6] = v[8 * i + 6] * r * g1.z; o8[7] = v[8 * i + 7] * r * g1.w;
      if (FINAL) {
        float4 a, b; a.x = o8[0]; a.y = o8[1]; a.z = o8[2]; a.w = o8[3]; b.x = o8[4]; b.y = o8[5]; b.z = o8[6]; b.w = o8[7];
        *(float4*)(fout + (size_t)t * DM + e0) = a; *(float4*)(fout + (size_t)t * DM + e0 + 4) = b;
      } else {
        u32x4 w4; w4[0] = pack2(o8[0], o8[1]); w4[1] = pack2(o8[2], o8[3]); w4[2] = pack2(o8[4], o8[5]); w4[3] = pack2(o8[6], o8[7]);
        *(u32x4*)(hout + (size_t)t * DM + e0) = w4;
      }
    }
  }
}


struct EpiInproj {
  static constexpr bool PERM = true, AFTER_DRAIN = false, MIDK = false;
  char* ws;
  DI void operator()(const f32x4 (&acc)[2][2][4][2], const pg8::Unit& u, int wr, int wc, int fr_in, int fq_in) const {
    int fr = fr_in, fq = fq_in; asm volatile("" : "+v"(fr), "+v"(fq));
    const float* rope = (const float*)(ws + OFF_ROPE);
    bf16_t* qa = (bf16_t*)(ws + OFF_QA); bf16_t* ka = (bf16_t*)(ws + OFF_KA); bf16_t* vaT = (bf16_t*)(ws + OFF_VAT);
    bf16_t* qb = (bf16_t*)(ws + OFF_QB); bf16_t* kb = (bf16_t*)(ws + OFF_KB); bf16_t* vb = (bf16_t*)(ws + OFF_VB);
    bf16_t* qi = (bf16_t*)(ws + OFF_QI); bf16_t* ki = (bf16_t*)(ws + OFF_KI); float* wi = (float*)(ws + OFF_WI);
    bf16_t* gates = (bf16_t*)(ws + OFF_GATES);
    const int cl8 = wc * 32 + 8 * fq;
    if (u.pn >= 10 && u.pn < 18) {
      bf16_t* gA = (bf16_t*)(ws + OFF_GATES); bf16_t* gR = gA + (size_t)T_TOK * 1024;
      const int ch0 = (u.pn - 10) * 128 + cl8;
#pragma unroll
      for (int ai = 0; ai < 2; ++ai)
#pragma unroll
        for (int m = 0; m < 4; ++m) {
          const int tok = u.pm * 256 + ai * 128 + wr * 64 + m * 16 + fr;
          f32x4 a0 = acc[ai][0][m][0], a1 = acc[ai][0][m][1], b0 = acc[ai][1][m][0], b1 = acc[ai][1][m][1];
#pragma unroll
          for (int j = 0; j < 4; ++j) {
            a0[j] = __builtin_amdgcn_rcpf(1.0f + __expf(-a0[j])); a1[j] = __builtin_amdgcn_rcpf(1.0f + __expf(-a1[j]));
            b0[j] = __builtin_amdgcn_rcpf(1.0f + __expf(-b0[j])); b1[j] = __builtin_amdgcn_rcpf(1.0f + __expf(-b1[j]));
          }
          const u32x4 wa4 = pack8(a0, a1);
          *(u32x4*)(gA + (size_t)tok * 1024 + ch0) = wa4;
          f32x4 r0, r1;
          r0[0] = b0[0] * __builtin_amdgcn_rcpf(fmaxf(bflo(wa4[0]), 1e-20f)); r0[1] = b0[1] * __builtin_amdgcn_rcpf(fmaxf(bfhi(wa4[0]), 1e-20f));
          r0[2] = b0[2] * __builtin_amdgcn_rcpf(fmaxf(bflo(wa4[1]), 1e-20f)); r0[3] = b0[3] * __builtin_amdgcn_rcpf(fmaxf(bfhi(wa4[1]), 1e-20f));
          r1[0] = b1[0] * __builtin_amdgcn_rcpf(fmaxf(bflo(wa4[2]), 1e-20f)); r1[1] = b1[1] * __builtin_amdgcn_rcpf(fmaxf(bfhi(wa4[2]), 1e-20f));
          r1[2] = b1[2] * __builtin_amdgcn_rcpf(fmaxf(bflo(wa4[3]), 1e-20f)); r1[3] = b1[3] * __builtin_amdgcn_rcpf(fmaxf(bfhi(wa4[3]), 1e-20f));
          *(u32x4*)(gR + (size_t)tok * 1024 + ch0) = pack8(r0, r1);
        }
      return;
    }
#pragma unroll
    for (int bj = 0; bj < 2; ++bj) {
      const int ni = u.pn * 2 + bj;
      if (ni >= 37) continue;
#pragma unroll
      for (int ai = 0; ai < 2; ++ai)
#pragma unroll
        for (int m = 0; m < 4; ++m) {
          const int tok = u.pm * 256 + ai * 128 + wr * 64 + m * 16 + fr;
          const int pos = tok & 4095;
          f32x4 v0 = acc[ai][bj][m][0], v1 = acc[ai][bj][m][1];
          if (ni < 8) {
            bf16_t* dst = (ni < 4) ? qa : ka;
            *(u32x4*)(dst + (size_t)tok * 512 + (ni & 3) * 128 + cl8) = pack8(v0, v1);
          } else if (ni < 12) {
            const int c = (ni - 8) * 128 + cl8; const int hd = c >> 6, d = c & 63; const int b = tok >> 12;
            bf16_t* dst = vaT + ((size_t)((b * 8 + hd) * 64 + d)) * SEQ + pos;
#pragma unroll
            for (int j = 0; j < 4; ++j) { dst[(size_t)j * SEQ] = f2bf(v0[j]); dst[(size_t)(j + 4) * SEQ] = f2bf(v1[j]); }
          } else if (ni < 17) {
            const int d0 = cl8 & 63;
            f32x4 p0, p1;
#pragma unroll
            for (int j = 0; j < 4; ++j) { p0[j] = __shfl_xor(v0[j], 16); p1[j] = __shfl_xor(v1[j], 16); }
            if (d0 < 16) {
              const f32x4 c0 = *(const f32x4*)(rope + pos * 24), c1 = *(const f32x4*)(rope + pos * 24 + 4);
              const f32x4 s0 = *(const f32x4*)(rope + pos * 24 + 8), s1 = *(const f32x4*)(rope + pos * 24 + 12);
              if (d0 == 0) { v0 = v0 * c0 - p0 * s0; v1 = v1 * c1 - p1 * s1; }
              else         { v0 = v0 * c0 + p0 * s0; v1 = v1 * c1 + p1 * s1; }
            }
            if (ni < 16) *(u32x4*)(qb + (size_t)tok * 512 + (ni - 12) * 128 + cl8) = pack8(v0, v1);
            else         *(u32x4*)(kb + (size_t)tok * 128 + cl8) = pack8(v0, v1);
          } else if (ni == 17) {
            *(u32x4*)(vb + (size_t)tok * 128 + cl8) = pack8(v0, v1);
          } else if (ni < 20 || ni == 36) {
            if ((cl8 & 31) == 0 && (ni < 20 || cl8 == 0)) {
              const f32x4 cs = *(const f32x4*)(rope + pos * 24 + 16), sn = *(const f32x4*)(rope + pos * 24 + 20);
              const f32x4 a = v0 * cs - v1 * sn, b2 = v1 * cs + v0 * sn;
              v0 = a; v1 = b2;
            }
            if (ni < 20) *(u32x4*)(qi + (size_t)tok * 256 + (ni - 18) * 128 + cl8) = pack8(v0, v1);
            else if (cl8 < 32) *(u32x4*)(ki + (size_t)(tok >> 4) * 512 + (cl8 >> 3) * 128 + (tok & 15) * 8) = pack8(v0, v1);
            else if (cl8 == 32) { *(f32x4*)(wi + (size_t)tok * 8) = v0 * 0.0625f; *(f32x4*)(wi + (size_t)tok * 8 + 4) = v1 * 0.0625f; }
          } else {
#pragma unroll
            for (int j = 0; j < 4; ++j) { v0[j] = __builtin_amdgcn_rcpf(1.0f + __expf(-v0[j])); v1[j] = __builtin_amdgcn_rcpf(1.0f + __expf(-v1[j])); }
            *(u32x4*)(gates + (size_t)tok * 2048 + (ni - 20) * 128 + cl8) = pack8(v0, v1);
          }
        }
    }
  }
};

struct EpiSqrelu {
  static constexpr bool PERM = true, AFTER_DRAIN = false, MIDK = false;
  bf16_t* O;
  DI void operator()(const f32x4 (&acc)[2][2][4][2], const pg8::Unit& u, int wr, int wc, int fr_in, int fq_in) const {
    int fr = fr_in, fq = fq_in; asm volatile("" : "+v"(fr), "+v"(fq));
#pragma unroll
    for (int ai = 0; ai < 2; ++ai)
#pragma unroll
      for (int m = 0; m < 4; ++m) {
        bf16_t* rowp = O + (size_t)(u.pm * 256 + ai * 128 + wr * 64 + m * 16 + fr) * 4096 + u.pn * 256 + wc * 32 + 8 * fq;
#pragma unroll
        for (int bj = 0; bj < 2; ++bj) {
          f32x4 v0 = acc[ai][bj][m][0], v1 = acc[ai][bj][m][1];
#pragma unroll
          for (int j = 0; j < 4; ++j) { const float a = fmaxf(v0[j], 0.f), b = fmaxf(v1[j], 0.f); v0[j] = a * a; v1[j] = b * b; }
          __builtin_nontemporal_store(pack8(v0, v1), (u32x4*)(rowp + bj * 128));
        }
      }
  }
};

template <bool RF32>
struct EpiResid {
  static constexpr bool PERM = true, AFTER_DRAIN = false, MIDK = false;
  const void* R; bf16_t* O;
  DI void operator()(const f32x4 (&acc)[2][2][4][2], const pg8::Unit& u, int wr, int wc, int fr_in, int fq_in) const {
    int fr = fr_in, fq = fq_in; asm volatile("" : "+v"(fr), "+v"(fq));
#pragma unroll
    for (int ai = 0; ai < 2; ++ai)
#pragma unroll
      for (int m = 0; m < 4; ++m) {
        const size_t ro = (size_t)(u.pm * 256 + ai * 128 + wr * 64 + m * 16 + fr) * 1024 + u.pn * 256 + wc * 32 + 8 * fq;
#pragma unroll
        for (int bj = 0; bj < 2; ++bj) {
          const size_t o = ro + bj * 128;
          f32x4 v0 = acc[ai][bj][m][0], v1 = acc[ai][bj][m][1];
          if (RF32) { v0 += *(const f32x4*)((const float*)R + o); v1 += *(const f32x4*)((const float*)R + o + 4); }
          else {
            const u32x4 rw = *(const u32x4*)((const bf16_t*)R + o);
            v0[0] += bflo(rw[0]); v0[1] += bfhi(rw[0]); v0[2] += bflo(rw[1]); v0[3] += bfhi(rw[1]);
            v1[0] += bflo(rw[2]); v1[1] += bfhi(rw[2]); v1[2] += bflo(rw[3]); v1[3] += bfhi(rw[3]);
          }
          *(u32x4*)(O + o) = pack8(v0, v1);
        }
      }
  }
};

template <int PASS>
struct EpiMerge {
  static constexpr bool PERM = true, AFTER_DRAIN = false, MIDK = false;
  const bf16_t* gates; bf16_t* O;
  DI void operator()(const f32x4 (&acc)[2][2][4][2], const pg8::Unit& u, int wr, int wc, int fr_in, int fq_in) const {
    int fr = fr_in, fq = fq_in; asm volatile("" : "+v"(fr), "+v"(fq));
#pragma unroll
    for (int ai = 0; ai < 2; ++ai)
#pragma unroll
      for (int m = 0; m < 4; ++m) {
        const int tok = u.pm * 256 + ai * 128 + wr * 64 + m * 16 + fr;
        const int c0 = u.pn * 256 + wc * 32 + 8 * fq;
#pragma unroll
        for (int bj = 0; bj < 2; ++bj) {
          const u32x4 gw = *(const u32x4*)(gates + (size_t)tok * 2048 + (PASS == 1 ? 1024 : 0) + c0 + bj * 128);
          f32x4 v0 = acc[ai][bj][m][0], v1 = acc[ai][bj][m][1];
          v0[0] *= bflo(gw[0]); v0[1] *= bfhi(gw[0]); v0[2] *= bflo(gw[1]); v0[3] *= bfhi(gw[1]);
          v1[0] *= bflo(gw[2]); v1[1] *= bfhi(gw[2]); v1[2] *= bflo(gw[3]); v1[3] *= bfhi(gw[3]);
          bf16_t* op = O + (size_t)tok * 1024 + c0 + bj * 128;
          if (PASS == 2) {
            const u32x4 tw = *(const u32x4*)op;
            v0[0] += bflo(tw[0]); v0[1] += bfhi(tw[0]); v0[2] += bflo(tw[1]); v0[3] += bfhi(tw[1]);
            v1[0] += bflo(tw[2]); v1[1] += bfhi(tw[2]); v1[2] += bflo(tw[3]); v1[3] += bfhi(tw[3]);
          }
          *(u32x4*)op = pack8(v0, v1);
        }
      }
  }
};

struct EpiMergeFused {
  static constexpr bool PERM = true, AFTER_DRAIN = false, MIDK = true;
  const bf16_t* gates; bf16_t* O;
  DI void mid(f32x4 (&acc)[2][2][4][2], const pg8::Unit& u, int wr, int wc, int fr_in, int fq_in) const {
    int fr = fr_in, fq = fq_in; asm volatile("" : "+v"(fr), "+v"(fq));
    const bf16_t* gR = gates + (size_t)T_TOK * 1024;
#pragma unroll
    for (int ai = 0; ai < 2; ++ai)
#pragma unroll
      for (int m = 0; m < 4; ++m) {
        const int tok = u.pm * 256 + ai * 128 + wr * 64 + m * 16 + fr;
        const int c0 = u.pn * 256 + wc * 32 + 8 * fq;
#pragma unroll
        for (int bj = 0; bj < 2; ++bj) {
          const u32x4 rw = *(const u32x4*)(gR + (size_t)tok * 1024 + c0 + bj * 128);
#pragma unroll
          for (int j = 0; j < 4; ++j) { acc[ai][bj][m][j >> 1][(j & 1) * 2] *= bflo(rw[j]); acc[ai][bj][m][j >> 1][(j & 1) * 2 + 1] *= bfhi(rw[j]); }
        }
      }
  }
  DI void operator()(const f32x4 (&acc)[2][2][4][2], const pg8::Unit& u, int wr, int wc, int fr_in, int fq_in) const {
    int fr = fr_in, fq = fq_in; asm volatile("" : "+v"(fr), "+v"(fq));
#pragma unroll
    for (int ai = 0; ai < 2; ++ai)
#pragma unroll
      for (int m = 0; m < 4; ++m) {
        const int tok = u.pm * 256 + ai * 128 + wr * 64 + m * 16 + fr;
        const int c0 = u.pn * 256 + wc * 32 + 8 * fq;
#pragma unroll
        for (int bj = 0; bj < 2; ++bj) {
          const u32x4 ga = *(const u32x4*)(gates + (size_t)tok * 1024 + c0 + bj * 128);
          f32x4 v0 = acc[ai][bj][m][0], v1 = acc[ai][bj][m][1];
          v0[0] *= fmaxf(bflo(ga[0]), 1e-20f); v0[1] *= fmaxf(bfhi(ga[0]), 1e-20f); v0[2] *= fmaxf(bflo(ga[1]), 1e-20f); v0[3] *= fmaxf(bfhi(ga[1]), 1e-20f);
          v1[0] *= fmaxf(bflo(ga[2]), 1e-20f); v1[1] *= fmaxf(bfhi(ga[2]), 1e-20f); v1[2] *= fmaxf(bflo(ga[3]), 1e-20f); v1[3] *= fmaxf(bfhi(ga[3]), 1e-20f);
          *(u32x4*)(O + (size_t)tok * 1024 + c0 + bj * 128) = pack8(v0, v1);
        }
      }
  }
};

template <class Epi>
DI void run_gemm(char* smem, const bf16_t* A, const bf16_t* Bt, int N, int K, const Epi& E) {
  pg8::Gemm g; g.A = A; g.Bt = Bt; g.M = T_TOK; g.N = N; g.K = K;
  int cblk = blockIdx.x; asm volatile("" : "+s"(cblk));
  pg8::StaticOrder S; S.init(T_TOK, N, gridDim.x, cblk);
  pg8::gemm_phase<Epi, pg8::StaticOrder, false>((PG8_LAS unsigned char*)smem, g, S, E, nullptr);
  __syncthreads();
}

DI void mixA_wave(const Params& p, int item, int lane) {
  char* ws = p.ws; asm volatile("" : "+s"(ws));
  const bf16_t* qa = (const bf16_t*)(ws + OFF_QA); const bf16_t* ka = (const bf16_t*)(ws + OFF_KA);
  const bf16_t* vaT = (const bf16_t*)(ws + OFF_VAT); bf16_t* Ya = (bf16_t*)(ws + OFF_YA);
  const int r = lane & 31, h = lane >> 5;
  const int bh = item & 63, qg = item >> 6;
  const int b = bh >> 3, hd = bh & 7;
  const int tq = qg * 32 + r;
  bf16x8 qf[4];
#pragma unroll
  for (int s = 0; s < 4; ++s) qf[s] = *(const bf16x8*)(qa + (size_t)(b * SEQ + tq) * 512 + hd * 64 + 16 * s + 8 * h);
  f32x16 o[2];
#pragma unroll
  for (int e = 0; e < 16; ++e) { o[0][e] = 0.f; o[1][e] = 0.f; }
  float carry = 0.f;
  const bf16_t* kcol = ka + (size_t)(b * SEQ + r) * 512 + hd * 64 + 8 * h;
  const bf16_t* vrow = vaT + ((size_t)((b * 8 + hd) * 64 + r)) * SEQ + 4 * h;
  bf16x8 kf[4];
#pragma unroll
  for (int s = 0; s < 4; ++s) kf[s] = *(const bf16x8*)(kcol + (size_t)(qg * 32) * 512 + 16 * s);
  for (int kt = qg; kt >= 0; --kt) {
    const int kbase = kt * 32;
    s16x4 vlo[2][2], vhi[2][2];
#pragma unroll
    for (int s2 = 0; s2 < 2; ++s2)
#pragma unroll
      for (int db = 0; db < 2; ++db) {
        const bf16_t* vp = vrow + (size_t)(32 * db) * SEQ + kbase + 16 * s2;
        vlo[s2][db] = *(const s16x4*)vp; vhi[s2][db] = *(const s16x4*)(vp + 8);
      }
    bf16x8 kn[4];
    const int knext = (kt > 0 ? kt - 1 : 0) * 32;
#pragma unroll
    for (int s = 0; s < 4; ++s) kn[s] = *(const bf16x8*)(kcol + (size_t)knext * 512 + 16 * s);
    f32x16 sacc;
#pragma unroll
    for (int e = 0; e < 16; ++e) sacc[e] = 0.f;
#pragma unroll
    for (int s = 0; s < 4; ++s) sacc = MFMA32(kf[s], qf[s], sacc);
    float z[16], L[16];
#pragma unroll
    for (int e = 0; e < 16; ++e) {
      z[e] = sacc[e] * 0.125f;
      const bool valid = (kbase + crow(e, h)) < tq;
      const float ex = __expf(-fabsf(z[e]));
      const float sp = fmaxf(z[e], 0.f) + __logf(1.0f + ex);
      L[e] = valid ? -sp : 0.f;
    }
    float G[4], Go[4];
#pragma unroll
    for (int g = 0; g < 4; ++g) { G[g] = (L[4 * g] + L[4 * g + 1]) + (L[4 * g + 2] + L[4 * g + 3]); Go[g] = __shfl_xor(G[g], 32); }
    float higher = 0.f;
    float a[16];
#pragma unroll
    for (int g = 3; g >= 0; --g) {
      const float base = carry + higher + (h == 0 ? Go[g] : 0.f);
      const float c3 = base + L[4 * g + 3];
      const float c2 = c3 + L[4 * g + 2];
      const float c1 = c2 + L[4 * g + 1];
      const float c0 = c1 + L[4 * g];
      const float cc[4] = {c0, c1, c2, c3};
#pragma unroll
      for (int rr = 0; rr < 4; ++rr) {
        const int e = 4 * g + rr;
        const bool valid = (kbase + crow(e, h)) < tq;
        a[e] = valid ? __expf(z[e] + cc[rr]) : 0.f;
      }
      higher += G[g] + Go[g];
    }
    carry += higher;
#pragma unroll
    for (int s2 = 0; s2 < 2; ++s2) {
      u32x4 pk;
#pragma unroll
      for (int j = 0; j < 4; ++j) pk[j] = pack2(a[8 * s2 + 2 * j], a[8 * s2 + 2 * j + 1]);
      const bf16x8 pf = __builtin_bit_cast(bf16x8, pk);
#pragma unroll
      for (int db = 0; db < 2; ++db) {
        const bf16x8 vf = __builtin_shufflevector(vlo[s2][db], vhi[s2][db], 0, 1, 2, 3, 4, 5, 6, 7);
        o[db] = MFMA32(vf, pf, o[db]);
      }
    }
#pragma unroll
    for (int s = 0; s < 4; ++s) kf[s] = kn[s];
    if (__ballot(carry < -60.0f) == ~0ull) break;
  }
#pragma unroll
  for (int db = 0; db < 2; ++db)
#pragma unroll
    for (int g = 0; g < 4; ++g) {
      u32x2 ov; ov[0] = pack2(o[db][4 * g], o[db][4 * g + 1]); ov[1] = pack2(o[db][4 * g + 2], o[db][4 * g + 3]);
      *(u32x2*)(Ya + (size_t)(b * SEQ + tq) * 1024 + 512 + hd * 64 + 32 * db + 8 * g + 4 * h) = ov;
    }
}

DI unsigned sortable(float v) {
  v = v + 0.0f;
  const unsigned u = __float_as_uint(v);
  return (u & 0x80000000u) ? ~u : (u | 0x80000000u);
}

typedef short s16x2_t __attribute__((ext_vector_type(2)));
DI float tile_score(const bf16x8& af, const bf16x8& kf, const s16x4& wa) {
  f32x4 ac = {0.f, 0.f, 0.f, 0.f};
  ac = MFMA16(af, kf, ac);
  const s16x2_t z2 = {0, 0};
  const s16x2_t r01 = __builtin_elementwise_max(__builtin_bit_cast(s16x2_t, pack2(ac[0], ac[1])), z2);
  const s16x2_t r23 = __builtin_elementwise_max(__builtin_bit_cast(s16x2_t, pack2(ac[2], ac[3])), z2);
  s16x4 rb; rb[0] = r01[0]; rb[1] = r01[1]; rb[2] = r23[0]; rb[3] = r23[1];
  f32x4 sc4 = {0.f, 0.f, 0.f, 0.f};
  sc4 = __builtin_amdgcn_mfma_f32_16x16x16bf16_1k(wa, rb, sc4, 0, 0, 0);
  return sc4[0];
}

DI int count_ge8(unsigned a0, unsigned a1, unsigned a2, unsigned a3, unsigned a4, unsigned a5, unsigned a6, unsigned a7, unsigned cand) {
  unsigned long long m0, m1, m2, m3, m4, m5, m6, m7;
  asm("v_cmp_ge_u32_e64 %0, %8, %16\n\tv_cmp_ge_u32_e64 %1, %9, %16\n\tv_cmp_ge_u32_e64 %2, %10, %16\n\tv_cmp_ge_u32_e64 %3, %11, %16\n\t"
      "v_cmp_ge_u32_e64 %4, %12, %16\n\tv_cmp_ge_u32_e64 %5, %13, %16\n\tv_cmp_ge_u32_e64 %6, %14, %16\n\tv_cmp_ge_u32_e64 %7, %15, %16"
      : "=s"(m0), "=s"(m1), "=s"(m2), "=s"(m3), "=s"(m4), "=s"(m5), "=s"(m6), "=s"(m7)
      : "v"(a0), "v"(a1), "v"(a2), "v"(a3), "v"(a4), "v"(a5), "v"(a6), "v"(a7), "v"(cand));
  return (__builtin_popcountll(m0) + __builtin_popcountll(m1)) + (__builtin_popcountll(m2) + __builtin_popcountll(m3))
       + (__builtin_popcountll(m4) + __builtin_popcountll(m5)) + (__builtin_popcountll(m6) + __builtin_popcountll(m7));
}

DI void count_ge8_pair(unsigned a0, unsigned a1, unsigned a2, unsigned a3, unsigned a4, unsigned a5, unsigned a6, unsigned a7, unsigned cand, int& ca, int& cb) {
  unsigned long long m0, m1, m2, m3, m4, m5, m6, m7;
  asm("v_cmp_ge_u32_e64 %0, %8, %16\n\tv_cmp_ge_u32_e64 %1, %9, %16\n\tv_cmp_ge_u32_e64 %2, %10, %16\n\tv_cmp_ge_u32_e64 %3, %11, %16\n\t"
      "v_cmp_ge_u32_e64 %4, %12, %16\n\tv_cmp_ge_u32_e64 %5, %13, %16\n\tv_cmp_ge_u32_e64 %6, %14, %16\n\tv_cmp_ge_u32_e64 %7, %15, %16"
      : "=s"(m0), "=s"(m1), "=s"(m2), "=s"(m3), "=s"(m4), "=s"(m5), "=s"(m6), "=s"(m7)
      : "v"(a0), "v"(a1), "v"(a2), "v"(a3), "v"(a4), "v"(a5), "v"(a6), "v"(a7), "v"(cand));
#define PCLO(m) __builtin_popcount((unsigned)(m))
#define PCHI(m) __builtin_popcount((unsigned)((m) >> 32))
  ca += (PCLO(m0) + PCLO(m1)) + (PCLO(m2) + PCLO(m3)) + (PCLO(m4) + PCLO(m5)) + (PCLO(m6) + PCLO(m7));
  cb += (PCHI(m0) + PCHI(m1)) + (PCHI(m2) + PCHI(m3)) + (PCHI(m4) + PCHI(m5)) + (PCHI(m6) + PCHI(m7));
}

DI void mixB_pair(const Params& p, int tokenA, char* smem, int lane, int w) {
  char* ws = p.ws; asm volatile("" : "+s"(ws));
  const bf16_t* qb = (const bf16_t*)(ws + OFF_QB); const bf16_t* kb = (const bf16_t*)(ws + OFF_KB);
  const bf16_t* vb = (const bf16_t*)(ws + OFF_VB); const bf16_t* qi = (const bf16_t*)(ws + OFF_QI);
  const bf16_t* ki = (const bf16_t*)(ws + OFF_KI); const float* wi = (const float*)(ws + OFF_WI);
  bf16_t* Yb = (bf16_t*)(ws + OFF_YA);
  char* wl_ = smem + w * WAVE_LDS;
  int* sidxA = (int*)wl_;
  int* sidxB = (int*)(wl_ + 16384);
  float* spl = (float*)(wl_ + 1024);
  bf16_t* pbf = (bf16_t*)(wl_ + 6144);
  char* vimg = wl_ + 8192;
  const int b = tokenA >> 12, pos = tokenA & 4095, qc = pos >> 6;
  const int nkeys = (qc + 1) * 64, nk64 = qc + 1;
  const int cntsel = nkeys <= 256 ? nkeys : 256;
  if (nkeys <= 256) {
    for (int s = lane; s < 256; s += 64) { const int v = (s < nkeys) ? s : 0; sidxA[s] = v; sidxB[s] = v; }
  } else {
    const int l15 = lane & 15, l4 = lane >> 4;
    const bool second = lane >= 32;
    const bf16x8 af = *(const bf16x8*)(qi + (size_t)(tokenA + (l15 >> 3)) * 256 + (l15 & 7) * 32 + 8 * l4);
    s16x4 wa;
    {
      const f32x4 wq = *(const f32x4*)(wi + (size_t)(tokenA + (l15 >> 3)) * 8 + 4 * (l4 & 1));
      const bool on = (l15 >> 3) == (l4 >> 1);
      u32x2 wp; wp[0] = on ? pack2(wq[0], wq[1]) : 0u; wp[1] = on ? pack2(wq[2], wq[3]) : 0u;
      wa = __builtin_bit_cast(s16x4, wp);
    }
    const char* kibase = (const char*)ki + (size_t)b * SEQ * 64;
    const unsigned kioff = (unsigned)(lane * 16);
    unsigned u[128];
#pragma unroll
    for (int i = 0; i < 128; ++i) u[i] = 0u;
#pragma unroll
    for (int c = 0; c < 16; ++c) {
      if (c * 4 < nk64) {
        bf16x8 kf[16];
#pragma unroll
        for (int t = 0; t < 16; ++t) kf[t] = *(const bf16x8*)(kibase + (size_t)(c * 16 + t) * 1024 + kioff);
#pragma unroll
        for (int rr = 0; rr < 8; ++rr) {
          const float s0 = tile_score(af, kf[2 * rr], wa), s1 = tile_score(af, kf[2 * rr + 1], wa);
          const float sv = (l4 & 1) ? s1 : s0;
          u[c * 8 + rr] = (c * 4 + (rr >> 1) < nk64) ? sortable(sv) : 0u;
        }
        __builtin_amdgcn_sched_barrier(0);
      }
    }
    unsigned thr = 0u;
    bool doneA = false, doneB = false;
    for (int bit = 31; bit >= 0; --bit) {
      const unsigned cand = thr | (1u << bit);
      int ca = 0, cb = 0;
#pragma unroll
      for (int c = 0; c < 16; ++c) {
        if (c * 4 < nk64) count_ge8_pair(u[c * 8], u[c * 8 + 1], u[c * 8 + 2], u[c * 8 + 3], u[c * 8 + 4], u[c * 8 + 5], u[c * 8 + 6], u[c * 8 + 7], cand, ca, cb);
      }
      const bool accA = ca >= 256, accB = cb >= 256;
      thr = (second ? accB : accA) ? cand : thr;
      doneA = doneA || (ca == 256); doneB = doneB || (cb == 256);
      if (doneA && doneB) break;
    }
    int* mylist = second ? sidxB : sidxA;
    const int keylo = 16 * (l4 & 1) + l15;
    int bA = 0, bB = 0;
#pragma unroll
    for (int c = 0; c < 16; ++c) {
      if (c * 4 < nk64) {
#pragma unroll
        for (int i = c * 8; i < c * 8 + 8; ++i) {
          const unsigned long long m = __ballot(u[i] > thr);
          const unsigned mlo = (unsigned)m, mhi = (unsigned)(m >> 32);
          const int plo = __builtin_popcount(mlo), phi = __builtin_popcount(mhi);
          const int pre = __builtin_amdgcn_mbcnt_hi(mhi, __builtin_amdgcn_mbcnt_lo(mlo, 0u)) - (second ? plo : 0);
          if (u[i] > thr) mylist[(second ? bB : bA) + pre] = 32 * i + keylo;
          bA += plo; bB += phi;
        }
      }
    }
    if (bA < 256 || bB < 256) {
      int eA = bA, eB = bB;
#pragma unroll
      for (int c = 0; c < 16; ++c) {
        if (c * 4 < nk64) {
#pragma unroll
          for (int i = c * 8; i < c * 8 + 8; ++i) {
            const unsigned long long m = __ballot(u[i] == thr);
            const unsigned mlo = (unsigned)m, mhi = (unsigned)(m >> 32);
            const int plo = __builtin_popcount(mlo), phi = __builtin_popcount(mhi);
            const int posn = (second ? eB : eA) + __builtin_amdgcn_mbcnt_hi(mhi, __builtin_amdgcn_mbcnt_lo(mlo, 0u)) - (second ? plo : 0);
            if (u[i] == thr && posn < 256) mylist[posn] = 32 * i + keylo;
            eA += plo; eB += phi;
          }
        }
      }
    }
  }
#pragma unroll 1
  for (int qsel = 0; qsel < 2; ++qsel) {
    const int token = tokenA + qsel;
    if (qsel == 1) {
      __builtin_amdgcn_fence(__ATOMIC_ACQ_REL, "wavefront");
      for (int s = lane; s < 256; s += 64) sidxA[s] = sidxB[s];
    }
    const int* sidx = sidxA;
  __builtin_amdgcn_fence(__ATOMIC_ACQ_REL, "wavefront");
  asm volatile("" : "+v"(lane));
  const int l15 = lane & 15, l4 = lane >> 4;
#pragma unroll 1
  for (int g = 0; g < 2; ++g) {
    bf16x8 qf0, qf1;
    {
      const bf16_t* qp = qb + (size_t)token * 512 + (g * 4 + (lane & 3)) * 64 + 8 * l4;
      qf0 = *(const bf16x8*)qp; qf1 = *(const bf16x8*)(qp + 32);
    }
    const char* kbbase = (const char*)kb + ((size_t)b * SEQ * 128 + g * 64) * 2;
    float mx[4] = {-INFINITY, -INFINITY, -INFINITY, -INFINITY};
    {
      const int ksl_ = lane >> 3, dch_ = lane & 7;
      u32x4 kk[32];
#pragma unroll
      for (int j = 0; j < 32; ++j) {
        const int key = sidx[j * 8 + ksl_];
        kk[j] = *(const u32x4*)(kbbase + (unsigned)(key * 256 + dch_ * 16));
      }
#pragma unroll
      for (int c = 0; c < 4; ++c) {
#pragma unroll
        for (int jj = 0; jj < 8; ++jj) {
          const int row = 8 * jj + ksl_;
          *(u32x4*)(vimg + row * 128 + ((dch_ ^ ((row >> 1) & 7)) * 16)) = kk[c * 8 + jj];
        }
        __builtin_amdgcn_fence(__ATOMIC_ACQ_REL, "wavefront");
#pragma unroll
        for (int tt = 0; tt < 4; ++tt) {
          const int t = c * 4 + tt;
          const int row = 16 * tt + l15, sw = (row >> 1) & 7;
          const bf16x8 k0 = *(const bf16x8*)(vimg + row * 128 + ((l4 ^ sw) * 16));
          const bf16x8 k1 = *(const bf16x8*)(vimg + row * 128 + (((4 + l4) ^ sw) * 16));
          f32x4 ac = {0.f, 0.f, 0.f, 0.f};
          ac = MFMA16(qf0, k0, ac);
          ac = MFMA16(qf1, k1, ac);
          const bool ok = (t * 16 + l15) < cntsel;
          f32x4 lgv;
#pragma unroll
          for (int i = 0; i < 4; ++i) { lgv[i] = ok ? ac[i] * 0.125f : -INFINITY; mx[i] = fmaxf(mx[i], lgv[i]); }
          float* dstp = (l4 == (t & 3)) ? (spl + (t * 16 + l15) * 4) : (spl + 1024 + lane * 4);
          *(f32x4*)dstp = lgv;
        }
        __builtin_amdgcn_fence(__ATOMIC_ACQ_REL, "wavefront");
      }
    }
    __builtin_amdgcn_sched_barrier(0);
    const int ksl = lane >> 3, dch = lane & 7;
    const char* vbase = (const char*)vb + ((size_t)b * SEQ * 128 + g * 64) * 2;
    u32x4 vv[32];
#pragma unroll
    for (int j = 0; j < 32; ++j) {
      const int key = sidx[j * 8 + ksl];
      vv[j] = *(const u32x4*)(vbase + (unsigned)(key * 256 + dch * 16));
    }
    __builtin_amdgcn_sched_barrier(0);
#pragma unroll
    for (int i = 0; i < 4; ++i) {
#pragma unroll
      for (int o = 1; o < 16; o <<= 1) mx[i] = fmaxf(mx[i], __shfl_xor(mx[i], o));
    }
    __builtin_amdgcn_fence(__ATOMIC_ACQ_REL, "wavefront");
    float sm[4] = {0.f, 0.f, 0.f, 0.f};
    {
      f32x4 lgq[4];
#pragma unroll
      for (int jj = 0; jj < 4; ++jj) lgq[jj] = *(const f32x4*)(spl + (4 * lane + jj) * 4);
#pragma unroll
      for (int i = 0; i < 4; ++i) {
        float pq[4];
#pragma unroll
        for (int jj = 0; jj < 4; ++jj) { pq[jj] = __expf(lgq[jj][i] - mx[i]); sm[i] += pq[jj]; }
        u32x2 w2; w2[0] = pack2(pq[0], pq[1]); w2[1] = pack2(pq[2], pq[3]);
        *(u32x2*)(pbf + i * 256 + 4 * lane) = w2;
      }
    }
#pragma unroll
    for (int i = 0; i < 4; ++i) {
#pragma unroll
      for (int o = 1; o < 64; o <<= 1) sm[i] += __shfl_xor(sm[i], o);
    }
    __builtin_amdgcn_fence(__ATOMIC_ACQ_REL, "wavefront");
    f32x4 oacc[4];
#pragma unroll
    for (int d = 0; d < 4; ++d) oacc[d] = (f32x4){0.f, 0.f, 0.f, 0.f};
    typedef __attribute__((address_space(3))) s16x4 lds_s16x4;
    const int tq = l15 >> 2, tp = l15 & 3;
#pragma unroll
    for (int c = 0; c < 4; ++c) {
#pragma unroll
      for (int jj = 0; jj < 8; ++jj) {
        const int row = 8 * jj + ksl, sw = ((row >> 1) & 1) | (((row >> 3) & 1) << 1);
        *(u32x4*)(vimg + row * 128 + ((dch ^ (sw << 1)) * 16)) = vv[c * 8 + jj];
      }
      __builtin_amdgcn_fence(__ATOMIC_ACQ_REL, "wavefront");
#pragma unroll
      for (int ks = 0; ks < 2; ++ks) {
        const bf16x8 pb = *(const bf16x8*)(pbf + (l15 & 3) * 256 + c * 64 + ks * 32 + 8 * l4);
#pragma unroll
        for (int d = 0; d < 4; ++d) {
          const int vrow_ = ks * 32 + 8 * l4 + tq, vsw_ = ((vrow_ >> 1) & 1) | (((vrow_ >> 3) & 1) << 1);
          const char* ap = vimg + vrow_ * 128 + (((d * 4 + tp) ^ (vsw_ << 2)) * 8);
          const s16x4 lo = __builtin_amdgcn_ds_read_tr16_b64_v4i16((lds_s16x4*)ap);
          const s16x4 hi = __builtin_amdgcn_ds_read_tr16_b64_v4i16((lds_s16x4*)(ap + 512));
          const bf16x8 va8 = __builtin_shufflevector(lo, hi, 0, 1, 2, 3, 4, 5, 6, 7);
          oacc[d] = MFMA16(va8, pb, oacc[d]);
        }
      }
      __builtin_amdgcn_fence(__ATOMIC_ACQ_REL, "wavefront");
    }
    {
      const int hd_ = l15 & 3;
      const float ssel = hd_ == 0 ? sm[0] : (hd_ == 1 ? sm[1] : (hd_ == 2 ? sm[2] : sm[3]));
      const float inv = 1.0f / ssel;
      if (l15 < 4) {
#pragma unroll
        for (int d = 0; d < 4; ++d) {
          u32x2 o; o[0] = pack2(oacc[d][0] * inv, oacc[d][1] * inv); o[1] = pack2(oacc[d][2] * inv, oacc[d][3] * inv);
          *(u32x2*)(Yb + (size_t)token * 1024 + (g * 4 + hd_) * 64 + d * 16 + 4 * l4) = o;
        }
      }
    }
    __builtin_amdgcn_fence(__ATOMIC_ACQ_REL, "wavefront");
  }

  }
}

DI void phase_mixers(const Params& p, char* smem) {
  const int tid = otid(), lane = tid & 63, w = __builtin_amdgcn_readfirstlane(tid >> 6);
  const int nwv = gridDim.x * NWAVE;
  const int wv = blockIdx.x * NWAVE + w;
  int itA = wv, jp = wv;
#pragma unroll 1
  for (int k = 0; itA < 64 * (SEQ / 32) || jp < T_TOK / 2; ++k) {
    if (itA < 64 * (SEQ / 32) && ((k & 1) == 0 || jp >= T_TOK / 2)) { mixA_wave(p, itA, lane); itA += nwv; }
    if (jp < T_TOK / 2) {
      const int bat = jp / (SEQ / 2), pidx = jp & (SEQ / 2 - 1);
      const int ppos = (bat & 1) ? (SEQ / 2 - 1 - pidx) : pidx;
      mixB_pair(p, bat * SEQ + 2 * ppos, smem, lane, w);
      jp += nwv;
    }
  }
  __syncthreads();
}

__global__ void __launch_bounds__(512) fwd_megakernel(Params p) {
  cg::grid_group grid = cg::this_grid();
  __shared__ __attribute__((aligned(1024))) char smem[LDS_BYTES];
  if (p.out == nullptr) grid.sync();
  __shared__ uint4 xb_words;
  if (otid() == 0) xb_words = make_uint4(0u, 0u, 0u, 0u);
  __syncthreads();
  const XcdBarrier xb = xcd_barrier_post((unsigned*)(p.ws + OFF_BAR), (volatile LAS unsigned*)&xb_words);
  phase_prep(p, smem);
  phase_rmsnorm<false, false>(p.x, p.g_mix, (bf16_t*)(p.ws + OFF_HBUF), nullptr);
  xcd_barrier(xb);
  bf16_t* xs = (bf16_t*)p.out;
#pragma unroll 1
  for (int layer = 0; layer < 2; ++layer) {
    char* wl = p.ws + (size_t)layer * WT_LAYER;
    bf16_t* hbuf = (bf16_t*)(p.ws + OFF_HBUF);
    if (layer > 0) {
      phase_rmsnorm<true, false>(xs, p.g_mix + DM, hbuf, nullptr);
      xcd_barrier(xb);
    }
    { EpiInproj E; E.ws = p.ws; run_gemm(smem, hbuf, (const bf16_t*)(wl + WT_IN), NPAD_IN, 1024, E); }
    xcd_barrier(xb);
    phase_mixers(p, smem);
    xcd_barrier(xb);
    { EpiMergeFused E; E.gates = (const bf16_t*)(p.ws + OFF_GATES); E.O = hbuf;
      run_gemm(smem, (const bf16_t*)(p.ws + OFF_YA), (const bf16_t*)(wl + WT_UPA), 1024, 1024, E); }
    xcd_barrier(xb);
    if (layer == 0) { EpiResid<true> E; E.R = p.x; E.O = xs; run_gemm(smem, hbuf, (const bf16_t*)(wl + WT_O), 1024, 1024, E); }
    else            { EpiResid<false> E; E.R = xs; E.O = xs; run_gemm(smem, hbuf, (const bf16_t*)(wl + WT_O), 1024, 1024, E); }
    xcd_barrier(xb);
    phase_rmsnorm<true, false>(xs, p.g_mlp + layer * DM, hbuf, nullptr);
    xcd_barrier(xb);
    { EpiSqrelu E; E.O = (bf16_t*)(p.ws + OFF_HIDDEN); run_gemm(smem, hbuf, (const bf16_t*)(wl + WT_FF1), 4096, 1024, E); }
    xcd_barrier(xb);
    { EpiResid<false> E; E.R = xs; E.O = layer == 0 ? xs : hbuf; run_gemm(smem, (const bf16_t*)(p.ws + OFF_HIDDEN), (const bf16_t*)(wl + WT_FF2), 1024, 4096, E); }
    xcd_barrier(xb);
  }
  phase_rmsnorm<true, true>((const bf16_t*)(p.ws + OFF_HBUF), p.g_final, nullptr, p.out);
}

extern "C" void kernel_launch(void* const* d_in, const int* in_sizes, int n_in,
                              void* d_out, int out_size, void* d_ws, size_t ws_size,
                              hipStream_t stream) {
  static int grid_blocks = 0;
  if (!grid_blocks) {
    int dev = 0, cus = 0, per_cu = 0;
    (void)hipGetDevice(&dev);
    (void)hipDeviceGetAttribute(&cus, hipDeviceAttributeMultiprocessorCount, dev);
    (void)hipOccupancyMaxActiveBlocksPerMultiprocessor(&per_cu, fwd_megakernel, NTHR, 0);
    if (per_cu > 1) per_cu = 1;
    if (per_cu < 1) per_cu = 1;
    grid_blocks = cus * per_cu;
  }
  Params p{};
  p.x = (const float*)d_in[0]; p.g_mix = (const float*)d_in[1]; p.w_in = (const float*)d_in[2];
  p.w_up_a = (const float*)d_in[3]; p.w_up_b = (const float*)d_in[4]; p.w_o = (const float*)d_in[5];
  p.g_mlp = (const float*)d_in[6]; p.w_ff1 = (const float*)d_in[7]; p.w_ff2 = (const float*)d_in[8];
  p.g_final = (const float*)d_in[9];
  p.out = (float*)d_out; p.ws = (char*)d_ws;
  (void)hipMemsetAsync((char*)d_ws + OFF_BAR, 0, XCD_BAR_WORDS * 4, stream);
  void* args[] = {&p};
  hipError_t e = hipLaunchCooperativeKernel((void*)fwd_megakernel, dim3(grid_blocks), dim3(NTHR), args, 0, stream);
  if (e != hipSuccess) fprintf(stderr, "cooperative launch failed: %s (grid %d)\n", hipGetErrorString(e), grid_blocks);
}
```
